# Optimizing an MI355X kernel written in HIP

```python
import math
import jax, jax.numpy as jnp
from jax import lax
import numpy as np

D_MODEL = 1024
BATCH = 16
SEQ = 2048
DEPTH = 2
DEC_BATCH = 32
DEC_SEQ = 2048
PAST_LEN = 128

DIFF_HEADS = 4
DIFF_DH = 64
DIFF_DV = 2 * DIFF_DH
DIFF_WIDTH = DIFF_HEADS * DIFF_DV
MLA_HEADS = 4
MLA_NOPE = 128
MLA_ROPE = 64
MLA_V = 128
Q_LORA = 256
KV_LORA = 128
MLA_WIDTH = MLA_HEADS * MLA_V
MIX_WIDTH = DIFF_WIDTH + MLA_WIDTH
IN_COLS = 3 * DIFF_WIDTH + Q_LORA + KV_LORA + MLA_ROPE
D_FF = ((8 * D_MODEL + 3 * 256 - 1) // (3 * 256)) * 256
ROPE_THETA = 10000.0
Q_BLOCK = 128
EPS = 1e-6

kernel_name = "hybrid_diffattn_mla_encoder"


def _rms(x, g):
    xf = x.astype(jnp.float32)
    y = xf * lax.rsqrt(jnp.mean(xf * xf, axis=-1, keepdims=True) + EPS)
    return (y * g.astype(jnp.float32)).astype(x.dtype)


def _rope(x, pos):
    d = x.shape[-1]
    half = d // 2
    inv = 1.0 / (ROPE_THETA ** (jnp.arange(half, dtype=jnp.float32) * 2.0 / d))
    ang = pos.astype(jnp.float32)[:, None] * inv[None, :]
    cos = jnp.cos(ang)[None, :, None, :]
    sin = jnp.sin(ang)[None, :, None, :]
    xf = x.astype(jnp.float32)
    x1, x2 = xf[..., :half], xf[..., half:]
    out = jnp.concatenate([x1 * cos - x2 * sin, x2 * cos + x1 * sin], axis=-1)
    return out.astype(x.dtype)


def _to_blocks(t):
    b, s = t.shape[:2]
    return t.reshape((b, s // Q_BLOCK, Q_BLOCK) + t.shape[2:]).swapaxes(0, 1)


def _from_blocks(t):
    nb, b, qb = t.shape[:3]
    return t.swapaxes(0, 1).reshape((b, nb * qb) + t.shape[3:])


def _diff_attention(q, k, v, lam, subln_g, lam_init):
    b, s = q.shape[:2]
    q = q.reshape(b, s, DIFF_HEADS, 2, DIFF_DH)
    k = k.reshape(b, s, DIFF_HEADS, 2, DIFF_DH)
    scale = DIFF_DH ** -0.5

    def blk(qb):
        sc = jnp.einsum('bqhcd,bkhcd->bhcqk', qb, k).astype(jnp.float32) * scale
        p = jax.nn.softmax(sc, axis=-1)
        a = p[:, :, 0] - lam * p[:, :, 1]
        return jnp.einsum('bhqk,bkhe->bqhe', a.astype(v.dtype), v)

    o = _from_blocks(lax.map(blk, _to_blocks(q)))
    o = _rms(o, subln_g) * (1.0 - lam_init)
    return o.reshape(b, s, DIFF_WIDTH)


def _mla_attention(q_nope, q_pe, k_nope, k_pe, v):
    b, s = q_nope.shape[:2]
    scale = (MLA_NOPE + MLA_ROPE) ** -0.5

    def blk(qs):
        qn, qp = qs
        sc = (jnp.einsum('bqhd,bkhd->bhqk', qn, k_nope)
              + jnp.einsum('bqhr,bkr->bhqk', qp, k_pe)).astype(jnp.float32) * scale
        p = jax.nn.softmax(sc, axis=-1)
        return jnp.einsum('bhqk,bkhd->bqhd', p.astype(v.dtype), v)

    o = _from_blocks(lax.map(blk, (_to_blocks(q_nope), _to_blocks(q_pe))))
    return o.reshape(b, s, MLA_WIDTH)


def _layer(x, pos, l, attn_norm, w_in, lam_q1, lam_k1, lam_q2, lam_k2, diff_subln,
           q_a_norm, w_q_b, kv_a_norm, w_kv_b, w_o, ffn_norm, w_gate, w_up, w_down):
    b, s, _ = x.shape
    h = _rms(x, attn_norm[l])
    z = h @ w_in[l]
    o1 = DIFF_WIDTH
    o2 = o1 + DIFF_WIDTH
    o3 = o2 + DIFF_WIDTH
    o4 = o3 + Q_LORA
    o5 = o4 + KV_LORA
    dq = _rope(z[..., :o1].reshape(b, s, 2 * DIFF_HEADS, DIFF_DH), pos)
    dk = _rope(z[..., o1:o2].reshape(b, s, 2 * DIFF_HEADS, DIFF_DH), pos)
    dv = z[..., o2:o3].reshape(b, s, DIFF_HEADS, DIFF_DV)
    c_q = z[..., o3:o4]
    c_kv = z[..., o4:o5]
    k_pe = z[..., o5:]

    lam_init = 0.8 - 0.6 * math.exp(-0.3 * l)
    lam = (jnp.exp(jnp.sum(lam_q1[l].astype(jnp.float32) * lam_k1[l].astype(jnp.float32)))
           - jnp.exp(jnp.sum(lam_q2[l].astype(jnp.float32) * lam_k2[l].astype(jnp.float32)))
           + lam_init)
    y_diff = _diff_attention(dq, dk, dv, lam, diff_subln[l], lam_init)

    qh = (_rms(c_q, q_a_norm[l]) @ w_q_b[l]).reshape(b, s, MLA_HEADS, MLA_NOPE + MLA_ROPE)
    q_nope = qh[..., :MLA_NOPE]
    q_pe = _rope(qh[..., MLA_NOPE:], pos)
    kvh = (_rms(c_kv, kv_a_norm[l]) @ w_kv_b[l]).reshape(b, s, MLA_HEADS, MLA_NOPE + MLA_V)
    k_nope = kvh[..., :MLA_NOPE]
    v = kvh[..., MLA_NOPE:]
    k_pe = _rope(k_pe[:, :, None, :], pos)[:, :, 0, :]
    y_mla = _mla_attention(q_nope, q_pe, k_nope, k_pe, v)

    x = x + jnp.concatenate([y_diff, y_mla], axis=-1) @ w_o[l]

    h = _rms(x, ffn_norm[l])
    x = x + (jax.nn.silu(h @ w_gate[l]) * (h @ w_up[l])) @ w_down[l]
    return x


def _trunk(x, attn_norm, w_in, lam_q1, lam_k1, lam_q2, lam_k2, diff_subln,
           q_a_norm, w_q_b, kv_a_norm, w_kv_b, w_o, ffn_norm, w_gate, w_up, w_down, final_norm):
    pos = jnp.arange(x.shape[1], dtype=jnp.int32)
    for l in range(DEPTH):
        x = _layer(x, pos, l, attn_norm, w_in, lam_q1, lam_k1, lam_q2, lam_k2, diff_subln,
                   q_a_norm, w_q_b, kv_a_norm, w_kv_b, w_o, ffn_norm, w_gate, w_up, w_down)
    return _rms(x, final_norm)


def setup_inputs(seed: int = 0) -> dict:
    key = jax.random.key(seed)
    ks = jax.random.split(key, 20)
    f32 = jnp.float32

    def w(k, shape, fan_in):
        return jax.random.normal(k, shape, f32) * (fan_in ** -0.5)

    def gain(k, shape):
        return 1.0 + 0.05 * jax.random.normal(k, shape, f32)

    return {
        "x_prompt": jax.random.normal(ks[0], (BATCH, SEQ, D_MODEL), f32),
        "x_sample": jax.random.normal(ks[1], (DEC_BATCH, DEC_SEQ, D_MODEL), f32),
        "attn_norm": gain(ks[2], (DEPTH, D_MODEL)),
        "w_in": w(ks[3], (DEPTH, D_MODEL, IN_COLS), D_MODEL),
        "lam_q1": 0.1 * jax.random.normal(ks[4], (DEPTH, DIFF_DH), f32),
        "lam_k1": 0.1 * jax.random.normal(ks[5], (DEPTH, DIFF_DH), f32),
        "lam_q2": 0.1 * jax.random.normal(ks[6], (DEPTH, DIFF_DH), f32),
        "lam_k2": 0.1 * jax.random.normal(ks[7], (DEPTH, DIFF_DH), f32),
        "diff_subln": gain(ks[8], (DEPTH, DIFF_DV)),
        "q_a_norm": gain(ks[9], (DEPTH, Q_LORA)),
        "w_q_b": w(ks[10], (DEPTH, Q_LORA, MLA_HEADS * (MLA_NOPE + MLA_ROPE)), Q_LORA),
        "kv_a_norm": gain(ks[11], (DEPTH, KV_LORA)),
        "w_kv_b": w(ks[12], (DEPTH, KV_LORA, MLA_HEADS * (MLA_NOPE + MLA_V)), KV_LORA),
        "w_o": w(ks[13], (DEPTH, MIX_WIDTH, D_MODEL), MIX_WIDTH),
        "ffn_norm": gain(ks[14], (DEPTH, D_MODEL)),
        "w_gate": w(ks[15], (DEPTH, D_MODEL, D_FF), D_MODEL),
        "w_up": w(ks[16], (DEPTH, D_MODEL, D_FF), D_MODEL),
        "w_down": w(ks[17], (DEPTH, D_FF, D_MODEL), D_FF),
        "final_norm": gain(ks[18], (D_MODEL,)),
    }


def reference(x_prompt, x_sample, attn_norm, w_in, lam_q1, lam_k1, lam_q2, lam_k2, diff_subln,
              q_a_norm, w_q_b, kv_a_norm, w_kv_b, w_o, ffn_norm, w_gate, w_up, w_down, final_norm):
    y_prompt = _trunk(x_prompt, attn_norm, w_in, lam_q1, lam_k1, lam_q2, lam_k2, diff_subln,
                      q_a_norm, w_q_b, kv_a_norm, w_kv_b, w_o, ffn_norm, w_gate, w_up, w_down, final_norm)
    y_sample = _trunk(x_sample, attn_norm, w_in, lam_q1, lam_k1, lam_q2, lam_k2, diff_subln,
                      q_a_norm, w_q_b, kv_a_norm, w_kv_b, w_o, ffn_norm, w_gate, w_up, w_down, final_norm)
    return (y_prompt, y_sample)
```

```cpp
#include <hip/hip_runtime.h>
#include <hip/hip_cooperative_groups.h>
#include <cstdio>
#include <cstdint>
namespace cg = cooperative_groups;
#ifndef PG8_SP2
#define PG8_SP2 true
#endif
#ifndef PG8_ALIGN
#define PG8_ALIGN true
#endif
__device__ __forceinline__ int ltid() { int t = threadIdx.x; asm volatile("" : "+v"(t)); return t; }
namespace pg8 {
#define PG8_LAS __attribute__((address_space(3)))
typedef unsigned short bf16_t;
typedef short bf16x8 __attribute__((ext_vector_type(8)));
typedef float f32x4 __attribute__((ext_vector_type(4)));
typedef unsigned u32x4 __attribute__((ext_vector_type(4)));
constexpr int BM = 256, BK = 64, HALF = 128, HTB = HALF * BK * 2  , STAGE_BYTES = 8 * HTB, NXCD = 8, WGM = 8;

__host__ __device__ __forceinline__ int lds_byte(int r, int c) { const int st = (r >> 4) * 2 + (c >> 5), rr = r & 15, cc = c & 31, ob = rr * 64 + cc * 2; return st * 1024 + (ob ^ (((ob >> 9) & 1) << 5)); }
__host__ __device__ __forceinline__ void stage_rc(int b, int& R, int& C) { const int st = b / 1024, sb = b % 1024, swz = sb ^ (((sb >> 9) & 1) << 5); R = (st >> 1) * 16 + swz / 64; C = (st & 1) * 32 + (swz % 64) / 2; }
__host__ __device__ __forceinline__ int perm32(int rho) { const int n = rho >> 4, i = rho & 15; return 8 * (i >> 2) + 4 * n + (i & 3); }

struct Unit { int pm, pn; };
struct Gemm { const bf16_t* A; const bf16_t* Bt; int M, N, K; };

struct StaticOrder {
    int nM, nN, nwg, G, c;
    __host__ __device__ void init(int M, int N, int G_, int c_) { nM = M / BM; nN = N / BM; nwg = nM * nN; G = G_; c = c_; }
    __host__ __device__ bool next(int i, Unit& u) const {
        const long L = (long)i * G + c; if (L >= nwg) return false;
        int wgid = (int)L; { const int q = nwg / NXCD, r = nwg % NXCD, xcd = wgid % NXCD, off = wgid / NXCD; wgid = (xcd < r ? xcd * (q + 1) : r * (q + 1) + (xcd - r) * q) + off; }
        const int nig = WGM * nN, gid = wgid / nig, fm = gid * WGM, gsz = (nM - fm) < WGM ? (nM - fm) : WGM;
        u.pm = fm + ((wgid % nig) % gsz); u.pn = (wgid % nig) / gsz; return true;
    }
    __device__ __forceinline__ void a_ready(const Unit&) const {}
    __device__ __forceinline__ void done(const Unit&) const {}
};
__device__ __forceinline__ unsigned cvt_pk_bf16(float lo, float hi) { unsigned r; asm volatile("v_cvt_pk_bf16_f32 %0, %1, %2" : "=v"(r) : "v"(lo), "v"(hi)); return r; }
template <class Epi, class Sched, bool ALIGN_EPI = false, bool SP2 = false>
__device__ __forceinline__ void gemm_phase(PG8_LAS unsigned char* lds, const Gemm g, const Sched& S, const Epi& E) {
    const int tid = ltid(), wid = __builtin_amdgcn_readfirstlane(tid >> 6), lane = tid & 63, wr = wid >> 2, wc = wid & 3, fr = lane & 15, fq = lane >> 4;
    const int K = g.K, nt = K / BK;
    unsigned voffA[2], voffB[2];
#pragma unroll
    for (int i = 0; i < 2; ++i) { int R, C; stage_rc(tid * 16 + i * 8192, R, C); const int Rb = Epi::PERM ? ((R & ~31) + perm32(R & 31)) : R;
        voffA[i] = (unsigned)(R * K + C) * 2u; voffB[i] = (unsigned)(Rb * K + C) * 2u; }
    const size_t kstep = (size_t)(BK * 2);
    const size_t hstep = (size_t)HALF * K * 2;
    const size_t tstep = 2 * hstep;
    const unsigned ldsw = (unsigned)wid * 1024u;
    const int aoff = lds_byte(wr * 64 + fr, fq * 8), boff = lds_byte(wc * 32 + fr, fq * 8);
#define PG8_SA(b, h) (((b) * 2 + (h)) * HTB)
#define PG8_SB(b, h) ((4 + (b) * 2 + (h)) * HTB)
#define PG8_STAGE(bufoff, gbase, voff) do { _Pragma("unroll") for (int _i = 0; _i < 2; ++_i) \
        __builtin_amdgcn_global_load_lds((const unsigned*)((const char*)(gbase) + (voff)[_i]), (PG8_LAS unsigned*)(lds + (bufoff) + ldsw + _i * 8192), 16, 0, 0); } while (0)
#define PG8_LDA(dst, b, h) do { _Pragma("unroll") for (int m = 0; m < 4; ++m) _Pragma("unroll") for (int k = 0; k < 2; ++k) dst[m][k] = *(const PG8_LAS bf16x8*)(lds + PG8_SA(b, h) + aoff + m * 2048 + k * 1024); } while (0)
#define PG8_LDB(dst, b, h) do { _Pragma("unroll") for (int n = 0; n < 2; ++n) _Pragma("unroll") for (int k = 0; k < 2; ++k) dst[n][k] = *(const PG8_LAS bf16x8*)(lds + PG8_SB(b, h) + boff + n * 2048 + k * 1024); } while (0)
#define PG8_MMA(ai, bj, At, Bt) do { __builtin_amdgcn_s_setprio(1); _Pragma("unroll") for (int m = 0; m < 4; ++m) _Pragma("unroll") for (int n = 0; n < 2; ++n) _Pragma("unroll") for (int k = 0; k < 2; ++k) \
        acc[ai][bj][m][n] = __builtin_amdgcn_mfma_f32_16x16x32_bf16(Bt[n][k], At[m][k], acc[ai][bj][m][n], 0, 0, 0); __builtin_amdgcn_s_setprio(0); } while (0)
#define PG8_WAIT_V(n) asm volatile("s_waitcnt vmcnt(" #n ")" ::: "memory")
#define PG8_WAIT_L(n) asm volatile("s_waitcnt lgkmcnt(" #n ")" ::: "memory")
#define PG8_BAR __builtin_amdgcn_s_barrier()
#define PG8_SCHED __builtin_amdgcn_sched_barrier(0)
    Unit cur, nxt; int ui = 0;
    if (!S.next(0, cur)) return;
    f32x4 acc[2][2][4][2];
#pragma unroll
    for (int a = 0; a < 2; ++a)
#pragma unroll
        for (int b = 0; b < 2; ++b)
#pragma unroll
            for (int m = 0; m < 4; ++m)
#pragma unroll
                for (int n = 0; n < 2; ++n) acc[a][b][m][n] = (f32x4){0.f, 0.f, 0.f, 0.f};
    bf16x8 At[4][2], B0[2][2], B1[2][2];
    const char* cA = (const char*)g.A + (size_t)cur.pm * tstep; const char* cB = (const char*)g.Bt + (size_t)cur.pn * tstep;
    S.a_ready(cur);
    if constexpr (SP2) {
        PG8_STAGE(PG8_SB(0, 0), cB, voffB); PG8_STAGE(PG8_SB(0, 1), cB + hstep, voffB); PG8_STAGE(PG8_SA(0, 0), cA, voffA); PG8_STAGE(PG8_SA(0, 1), cA + hstep, voffA);
        if (wr == 1) PG8_BAR;
        PG8_WAIT_V(2); PG8_BAR;
        PG8_STAGE(PG8_SB(1, 0), cB + kstep, voffB); PG8_STAGE(PG8_SA(1, 0), cA + kstep, voffA); PG8_STAGE(PG8_SB(1, 1), cB + hstep + kstep, voffB);
        PG8_WAIT_V(6); PG8_BAR;
    } else {
        PG8_STAGE(PG8_SB(0, 0), cB, voffB); PG8_STAGE(PG8_SA(0, 0), cA, voffA); PG8_STAGE(PG8_SB(0, 1), cB + hstep, voffB); PG8_STAGE(PG8_SA(0, 1), cA + hstep, voffA);
        if (wr == 1) PG8_BAR;
        PG8_WAIT_V(4); PG8_BAR;
        PG8_STAGE(PG8_SB(1, 0), cB + kstep, voffB); PG8_STAGE(PG8_SA(1, 0), cA + kstep, voffA); PG8_STAGE(PG8_SB(1, 1), cB + hstep + kstep, voffB);
        PG8_WAIT_V(6); PG8_BAR;
    }
    for (;;) {
        const bool has_next = S.next(ui + 1, nxt);
        const char* nA = has_next ? (const char*)g.A + (size_t)nxt.pm * tstep : cA; const char* nB = has_next ? (const char*)g.Bt + (size_t)nxt.pn * tstep : cB;
        for (int t = 0; t < nt; t += 2) {
            const bool last = (t == nt - 2);
            const char* a1 = cA + (size_t)(t + 1) * kstep;
            const char* a2 = last ? nA : cA + (size_t)(t + 2) * kstep; const char* b2 = last ? nB : cB + (size_t)(t + 2) * kstep;
            const char* a3 = a2 + kstep; const char* b3 = b2 + kstep;
            if (last && has_next) S.a_ready(nxt);
            if constexpr (SP2) {
            PG8_LDB(B0, 0, 0); PG8_LDB(B1, 0, 1); PG8_SCHED; PG8_LDA(At, 0, 0); PG8_STAGE(PG8_SA(1, 1), a1 + hstep, voffA);
            PG8_WAIT_V(8); PG8_WAIT_L(0); PG8_BAR; PG8_MMA(0, 0, At, B0); PG8_MMA(0, 1, At, B1); PG8_BAR; PG8_SCHED;
            PG8_LDA(At, 0, 1); PG8_STAGE(PG8_SB(0, 0), b2, voffB); PG8_STAGE(PG8_SB(0, 1), b2 + hstep, voffB); PG8_STAGE(PG8_SA(0, 0), a2, voffA);
            PG8_WAIT_V(8); PG8_WAIT_L(0); PG8_BAR; PG8_MMA(1, 0, At, B0); PG8_MMA(1, 1, At, B1); PG8_BAR; PG8_SCHED;
            PG8_LDB(B0, 1, 0); PG8_LDB(B1, 1, 1); PG8_SCHED; PG8_LDA(At, 1, 0); PG8_STAGE(PG8_SA(0, 1), a2 + hstep, voffA);
            PG8_WAIT_V(8); PG8_WAIT_L(0); PG8_BAR; PG8_MMA(0, 0, At, B0); PG8_MMA(0, 1, At, B1); PG8_BAR; PG8_SCHED;
            PG8_LDA(At, 1, 1); PG8_STAGE(PG8_SB(1, 0), b3, voffB); PG8_STAGE(PG8_SB(1, 1), b3 + hstep, voffB); PG8_STAGE(PG8_SA(1, 0), a3, voffA);
            PG8_WAIT_V(8); PG8_WAIT_L(0); PG8_BAR; PG8_MMA(1, 0, At, B0); PG8_MMA(1, 1, At, B1); PG8_BAR; PG8_SCHED;
            } else {
            PG8_LDB(B0, 0, 0); PG8_SCHED; PG8_LDA(At, 0, 0); PG8_STAGE(PG8_SA(1, 1), a1 + hstep, voffA);
            PG8_WAIT_L(8); PG8_BAR; PG8_WAIT_L(0); PG8_MMA(0, 0, At, B0); PG8_BAR; PG8_SCHED;
            PG8_LDB(B1, 0, 1); PG8_STAGE(PG8_SB(0, 0), b2, voffB);
            PG8_BAR; PG8_WAIT_L(0); PG8_MMA(0, 1, At, B1); PG8_BAR;
            PG8_LDA(At, 0, 1); PG8_STAGE(PG8_SA(0, 0), a2, voffA);
            PG8_BAR; PG8_WAIT_L(0); PG8_MMA(1, 0, At, B0); PG8_BAR; PG8_SCHED;
            PG8_STAGE(PG8_SB(0, 1), b2 + hstep, voffB);
            PG8_WAIT_V(6); PG8_BAR; PG8_MMA(1, 1, At, B1); PG8_BAR;
            PG8_LDB(B0, 1, 0); PG8_SCHED; PG8_LDA(At, 1, 0); PG8_STAGE(PG8_SA(0, 1), a2 + hstep, voffA);
            PG8_WAIT_L(8); PG8_BAR; PG8_WAIT_L(0); PG8_MMA(0, 0, At, B0); PG8_BAR; PG8_SCHED;
            PG8_LDB(B1, 1, 1); PG8_STAGE(PG8_SB(1, 0), b3, voffB);
            PG8_BAR; PG8_WAIT_L(0); PG8_MMA(0, 1, At, B1); PG8_BAR;
            PG8_LDA(At, 1, 1); PG8_STAGE(PG8_SA(1, 0), a3, voffA);
            PG8_BAR; PG8_WAIT_L(0); PG8_MMA(1, 0, At, B0); PG8_BAR; PG8_SCHED;
            PG8_STAGE(PG8_SB(1, 1), b3 + hstep, voffB);
            PG8_WAIT_V(6); PG8_BAR; PG8_MMA(1, 1, At, B1); PG8_BAR;
            }
        }
        if constexpr (ALIGN_EPI) { if (wr == 0) PG8_BAR; }
        if constexpr (!Epi::AFTER_DRAIN) { E(acc, cur, wr, wc, fr, fq); S.done(cur); }
        if (!has_next) break;
#pragma unroll
        for (int a = 0; a < 2; ++a)
#pragma unroll
            for (int b = 0; b < 2; ++b)
#pragma unroll
                for (int m = 0; m < 4; ++m)
#pragma unroll
                    for (int n = 0; n < 2; ++n) acc[a][b][m][n] = (f32x4){0.f, 0.f, 0.f, 0.f};
        cur = nxt; cA = nA; cB = nB; ++ui;
        if constexpr (ALIGN_EPI) { if (wr == 1) PG8_BAR; }
    }
    PG8_WAIT_V(0);
    if constexpr (!ALIGN_EPI) { if (wr == 0) PG8_BAR; }
    PG8_BAR;
    if constexpr (Epi::AFTER_DRAIN) { E.fused(acc, cur, wr, wc, fr, fq, lds, wid, lane); S.done(cur); }
#undef PG8_SA
#undef PG8_SB
#undef PG8_STAGE
#undef PG8_LDA
#undef PG8_LDB
#undef PG8_MMA
#undef PG8_WAIT_V
#undef PG8_WAIT_L
#undef PG8_BAR
#undef PG8_SCHED
}
}

constexpr int DM = 1024, SEQ = 2048, DEPTH = 2, DFF = 2816;
constexpr int ROWS0 = 16 * 2048, ROWS1 = 32 * 2048, MTOT = ROWS0 + ROWS1, RMAX = MTOT, NCH = 1;
constexpr int IN_COLS = 1984, IN_PHYS = 2048, GU_PHYS = 2 * DFF;
constexpr float EPS = 1e-6f;
constexpr float LOG2E = 1.4426950408889634f;
constexpr float QSCALE_D = 0.125f * LOG2E;
constexpr float QSCALE_M = 0.07216878364870322f * LOG2E;
constexpr int NWAVES = 8, NTHR = 512;
#ifndef REPK
#define REPK -2
#endif
#ifndef PHMASK
#define PHMASK 0xFFFF
#endif

using pg8::bf16_t; using pg8::bf16x8; using pg8::f32x4; using pg8::u32x4; using pg8::Unit; using pg8::cvt_pk_bf16;

constexpr size_t MiB = 1u << 20;
constexpr size_t WS_W = 0, W_LAYER = 25 * MiB;
constexpr size_t OW_IN = 0, OW_Q = 4 * MiB, OW_O = 6 * MiB, OW_GU = 8 * MiB, OW_D = 19 * MiB;
static_assert(OW_Q + 1792 * 384 * 2 <= OW_O && OW_D + (size_t)DM * DFF * 2 <= W_LAYER, "weight map");
constexpr size_t WS_ROPE = 50 * MiB, WS_SSQ = 842 * MiB, WS_BAR = 55 * MiB, BAR_BYTES = 16384, WS_STASH = 56 * MiB;
constexpr size_t WS_XB = 88 * MiB;
constexpr size_t WS_VD = 280 * MiB, WS_CQ = 376 * MiB, WS_QM = 448 * MiB, WS_KM = 592 * MiB, WS_VM = 736 * MiB, WS_END = 850 * MiB;
constexpr size_t WS_ACT = 280 * MiB;
constexpr size_t DO_AO = 0, DO_QD = 192 * MiB, DO_KD = 288 * MiB;
static_assert(WS_ACT + (size_t)RMAX * DFF * 2 <= 832 * MiB && WS_SSQ + (size_t)9 * MTOT * 8 <= WS_END && WS_XB + (size_t)MTOT * DM * 2 <= WS_VD, "workspace map");
constexpr int LDS_BYTES = 135168;

#define GAS __attribute__((address_space(1)))
__device__ __forceinline__ void st8(bf16_t* p, f32x4 a, f32x4 b) {
    u32x4 w; w.x = cvt_pk_bf16(a[0], a[1]); w.y = cvt_pk_bf16(a[2], a[3]); w.z = cvt_pk_bf16(b[0], b[1]); w.w = cvt_pk_bf16(b[2], b[3]);
    *(GAS u32x4*)p = w;
}
__device__ __forceinline__ f32x4 ld4g(const float* p) { return *(const GAS f32x4*)p; }
__device__ __forceinline__ float ld1g(const float* p) { return *(const GAS float*)p; }
__device__ __forceinline__ void st4g(float* p, f32x4 v) { *(GAS f32x4*)p = v; }
typedef unsigned long long u64;
constexpr float SSQ_FX = 16777216.0f, SSQ_IFX = 1.0f / 16777216.0f;
__device__ __forceinline__ void atomg(u64* p, float v) { (void)__hip_atomic_fetch_add((GAS u64*)p, (u64)(v * SSQ_FX), __ATOMIC_RELAXED, __HIP_MEMORY_SCOPE_AGENT); }
__device__ __forceinline__ float ldssq(const u64* p) { return (float)(*(const GAS u64*)p) * SSQ_IFX; }
__device__ __forceinline__ float sq8(f32x4 a, f32x4 b) { return (a[0] * a[0] + a[1] * a[1]) + (a[2] * a[2] + a[3] * a[3]) + (b[0] * b[0] + b[1] * b[1]) + (b[2] * b[2] + b[3] * b[3]); }
__device__ __forceinline__ float red_fq(float s) { s += __shfl_xor(s, 16); s += __shfl_xor(s, 32); return s; }
__device__ __forceinline__ void rope8r(f32x4 c0, f32x4 c1, f32x4 s0, f32x4 s1, f32x4& a0, f32x4& a1, f32x4& b0, f32x4& b1) {
    const f32x4 x0 = a0 * c0 - b0 * s0, x1 = a1 * c1 - b1 * s1, y0 = b0 * c0 + a0 * s0, y1 = b1 * c1 + a1 * s1;
    a0 = x0; a1 = x1; b0 = y0; b1 = y1;
}

struct EpiIn {
    static constexpr bool PERM = true, AFTER_DRAIN = false;
    bf16_t *Qd, *Kd, *Vd, *CQ, *CKV, *Km; const u64* ssq_in; u64* ssq_q; u64* ssq_kv; const float* rope;
    __device__ __forceinline__ void operator()(const f32x4 (&acc)[2][2][4][2], const Unit& u, int wr, int wc, int fr, int fq) const {
        { const int ln_ = ltid() & 63; fr = ln_ & 15; fq = ln_ >> 4; }
        const int pn = u.pn;
        const bool roped = (pn < 4) || (pn == 7 && wc == 3);
        const int row0 = u.pm * 256 + wr * 64 + fr;
        float rs[4][2]; f32x4 tb[4][2][4];
        f32x4 v[4][2][4];
#define EPI_ROW(b, mm) (row0 + ((b) >> 1) * 128 + (2 * ((b) & 1) + (mm)) * 16)
#define EPI_IN_LOAD(b) do { _Pragma("unroll") for (int mm = 0; mm < 2; ++mm) { const int row = EPI_ROW(b, mm); rs[b][mm] = ldssq(ssq_in + row); \
            if (roped) { const float* tab = rope + (row & (SEQ - 1)) * 64 + 8 * fq; tb[b][mm][0] = ld4g(tab); tb[b][mm][1] = ld4g(tab + 4); tb[b][mm][2] = ld4g(tab + 32); tb[b][mm][3] = ld4g(tab + 36); } } } while (0)
#define EPI_IN_COMP(b) do { _Pragma("unroll") for (int mm = 0; mm < 2; ++mm) { const float r = __builtin_amdgcn_rsqf(rs[b][mm] * (1.0f / 1024.0f) + EPS) * ((pn < 2) ? QSCALE_D : 1.0f); \
            const int ai = (b) >> 1, m = 2 * ((b) & 1) + mm; \
            v[b][mm][0] = acc[ai][0][m][0] * r; v[b][mm][1] = acc[ai][0][m][1] * r; v[b][mm][2] = acc[ai][1][m][0] * r; v[b][mm][3] = acc[ai][1][m][1] * r; \
            if (roped) rope8r(tb[b][mm][0], tb[b][mm][1], tb[b][mm][2], tb[b][mm][3], v[b][mm][0], v[b][mm][1], v[b][mm][2], v[b][mm][3]); } } while (0)
#define EPI_IN_STORE(b) do { _Pragma("unroll") for (int mm = 0; mm < 2; ++mm) { const int row = EPI_ROW(b, mm); \
            const f32x4 a0 = v[b][mm][0], a1 = v[b][mm][1], b0 = v[b][mm][2], b1 = v[b][mm][3]; \
            if (pn < 4) { bf16_t* dst = (pn < 2 ? Qd : Kd) + (size_t)row * 512 + (pn & 1) * 256 + wc * 64 + 8 * fq; st8(dst, a0, a1); st8(dst + 32, b0, b1); } \
            else if (pn < 6) { bf16_t* dst = Vd + (size_t)row * 512 + (pn - 4) * 256 + wc * 32 + 8 * fq; st8(dst, a0, a1); st8(dst + 128, b0, b1); } \
            else if (pn == 6) { bf16_t* dst = CQ + (size_t)row * 256 + wc * 32 + 8 * fq; st8(dst, a0, a1); st8(dst + 128, b0, b1); \
                const float s = red_fq(sq8(a0, a1) + sq8(b0, b1)); if (fq == 0) atomg(ssq_q + row, s); } \
            else if (wc < 3) { st8(Km + (size_t)row * 192 + wc * 32 + 8 * fq, a0, a1); float s = sq8(a0, a1); \
                if (wc == 0) { st8(Km + (size_t)row * 192 + 96 + 8 * fq, b0, b1); s += sq8(b0, b1); } \
                s = red_fq(s); if (fq == 0) atomg(ssq_kv + row, s); } \
            else { bf16_t* dst = Km + (size_t)row * 192 + 128 + 8 * fq; st8(dst, a0, a1); st8(dst + 32, b0, b1); } } } while (0)
        EPI_IN_LOAD(0); EPI_IN_COMP(0); EPI_IN_LOAD(1); EPI_IN_STORE(0); EPI_IN_COMP(1); EPI_IN_LOAD(2); EPI_IN_STORE(1); EPI_IN_COMP(2); EPI_IN_LOAD(3); EPI_IN_STORE(2); EPI_IN_COMP(3); EPI_IN_STORE(3);
#undef EPI_IN_LOAD
#undef EPI_IN_COMP
#undef EPI_IN_STORE
    }
};

struct EpiQKV {
    static constexpr bool PERM = true, AFTER_DRAIN = false;
    bf16_t *Qm, *Km, *Vm; const u64 *ssq_q, *ssq_kv; const float* rope;
    __device__ __forceinline__ void operator()(const f32x4 (&acc)[2][2][4][2], const Unit& u, int wr, int wc, int fr, int fq) const {
        const int pn = u.pn;
        const u64* ssq = pn < 3 ? ssq_q : ssq_kv; const float invk = pn < 3 ? (1.0f / 256.0f) : (1.0f / 128.0f), sc = pn < 3 ? QSCALE_M : 1.0f;
        char* d0; char* d1; unsigned ld0, ld1;
        if (pn < 2) { d0 = (char*)(Qm + (2 * pn) * 192 + wc * 32); d1 = d0 + 192 * 2; ld0 = ld1 = 768 * 2; }
        else if (pn == 2) { d0 = (char*)(Qm + wc * 192 + 128); d1 = d0 + 32 * 2; ld0 = ld1 = 768 * 2; }
        else { d0 = (char*)(Km + (pn - 3) * 192 + wc * 32); d1 = (char*)(Vm + (pn - 3) * 128 + wc * 32); ld0 = 768 * 2; ld1 = 512 * 2; }
        { const int ln_ = ltid() & 63; fr = ln_ & 15; fq = ln_ >> 4; }
        const unsigned row0 = u.pm * 256 + wr * 64 + fr, lo = 16 * fq;
#pragma unroll
        for (int ai = 0; ai < 2; ++ai)
#pragma unroll
            for (int m = 0; m < 4; ++m) {
                const unsigned row = row0 + ai * 128 + m * 16;
                const float r = __builtin_amdgcn_rsqf(ldssq(ssq + row) * invk + EPS) * sc;
                f32x4 a0 = acc[ai][0][m][0] * r, a1 = acc[ai][0][m][1] * r, b0 = acc[ai][1][m][0] * r, b1 = acc[ai][1][m][1] * r;
                if (pn == 2) { const float* tab = rope + (row & (SEQ - 1)) * 64 + 8 * fq; rope8r(ld4g(tab), ld4g(tab + 4), ld4g(tab + 32), ld4g(tab + 36), a0, a1, b0, b1); }
                st8((bf16_t*)(d0 + (row * ld0 + lo)), a0, a1); st8((bf16_t*)(d1 + (row * ld1 + lo)), b0, b1);
            }
#define EPI_Q_LOAD(b)
#define EPI_Q_COMP(b)
#define EPI_Q_STORE(b)
#undef EPI_Q_LOAD
#undef EPI_Q_COMP
#undef EPI_Q_STORE
    }
};

struct EpiRes {
    static constexpr bool PERM = true, AFTER_DRAIN = false;
    bf16_t* X; u64* ssq_out;
    __device__ __forceinline__ void operator()(const f32x4 (&acc)[2][2][4][2], const Unit& u, int wr, int wc, int fr, int fq) const {
        { const int ln_ = ltid() & 63; fr = ln_ & 15; fq = ln_ >> 4; }
        const size_t off0 = (size_t)(u.pm * 256 + wr * 64 + fr) * 1024 + u.pn * 256 + wc * 32 + 8 * fq;
        const int row0 = u.pm * 256 + wr * 64 + fr;
        u32x4 xin[2][4][2];
        f32x4 v[2][4][2][2];
#define EPI_R_LOAD(ai) do { _Pragma("unroll") for (int m = 0; m < 4; ++m) _Pragma("unroll") for (int bj = 0; bj < 2; ++bj) \
            xin[ai][m][bj] = *(const GAS u32x4*)(X + off0 + (size_t)((ai) * 128 + m * 16) * 1024 + bj * 128); } while (0)
#define EPI_R_COMP(ai) do { _Pragma("unroll") for (int m = 0; m < 4; ++m) _Pragma("unroll") for (int bj = 0; bj < 2; ++bj) { const u32x4 w = xin[ai][m][bj]; \
            const f32x4 x0 = {__uint_as_float(w.x << 16), __uint_as_float(w.x & 0xffff0000u), __uint_as_float(w.y << 16), __uint_as_float(w.y & 0xffff0000u)}; \
            const f32x4 x1 = {__uint_as_float(w.z << 16), __uint_as_float(w.z & 0xffff0000u), __uint_as_float(w.w << 16), __uint_as_float(w.w & 0xffff0000u)}; \
            v[ai][m][bj][0] = x0 + acc[ai][bj][m][0]; v[ai][m][bj][1] = x1 + acc[ai][bj][m][1]; } } while (0)
#define EPI_R_STORE(ai) do { _Pragma("unroll") for (int m = 0; m < 4; ++m) { float s = 0.f; const int rr = (ai) * 128 + m * 16; \
            _Pragma("unroll") for (int bj = 0; bj < 2; ++bj) { st8(X + off0 + (size_t)rr * 1024 + bj * 128, v[ai][m][bj][0], v[ai][m][bj][1]); s += sq8(v[ai][m][bj][0], v[ai][m][bj][1]); } \
            s = red_fq(s); if (fq == 0) atomg(ssq_out + row0 + rr, s); } } while (0)
        EPI_R_LOAD(0); EPI_R_LOAD(1); EPI_R_COMP(0); EPI_R_STORE(0); EPI_R_COMP(1); EPI_R_STORE(1);
#undef EPI_R_LOAD
#undef EPI_R_COMP
#undef EPI_R_STORE
    }
};

struct EpiGU {
    static constexpr bool PERM = true, AFTER_DRAIN = false;
    bf16_t* ACT; const u64* ssq_ffn;
    __device__ __forceinline__ void operator()(const f32x4 (&acc)[2][2][4][2], const Unit& u, int wr, int wc, int fr, int fq) const {
        { const int ln_ = ltid() & 63; fr = ln_ & 15; fq = ln_ >> 4; }
        const int row0 = u.pm * 256 + wr * 64 + fr;
        float rs[2][4];
#pragma unroll
        for (int ai = 0; ai < 2; ++ai)
#pragma unroll
            for (int m = 0; m < 4; ++m) rs[ai][m] = ldssq(ssq_ffn + row0 + ai * 128 + m * 16);
#pragma unroll
        for (int ai = 0; ai < 2; ++ai)
#pragma unroll
            for (int m = 0; m < 4; ++m) {
                const int row = row0 + ai * 128 + m * 16;
                const float r = __builtin_amdgcn_rsqf(rs[ai][m] * (1.0f / 1024.0f) + EPS);
                f32x4 o[2];
#pragma unroll
                for (int n = 0; n < 2; ++n) {
                    const f32x4 g = acc[ai][0][m][n] * r, up = acc[ai][1][m][n] * r;
#pragma unroll
                    for (int j = 0; j < 4; ++j) { const float e = __builtin_amdgcn_exp2f(-g[j] * LOG2E); o[n][j] = g[j] * up[j] * __builtin_amdgcn_rcpf(1.0f + e); }
                }
                st8(ACT + (size_t)row * DFF + u.pn * 128 + wc * 32 + 8 * fq, o[0], o[1]);
            }
    }
};

namespace att {
typedef short s16x4 __attribute__((ext_vector_type(4)));
typedef float f32x16 __attribute__((ext_vector_type(16)));
constexpr int KVBLK = 64, SHM_V = 16384, LDS_V = 0, LDS_K = 32768, SHM_KMAX = 24576, LDS_WS = LDS_K + 2 * SHM_KMAX;
constexpr float THR_L2 = 11.5f;
#define SBAR() __builtin_amdgcn_sched_barrier(0)
__device__ __forceinline__ int crow(int r, int hi) { return (r & 3) + 8 * (r >> 2) + 4 * hi; }
__device__ __forceinline__ unsigned cvtpk(float lo, float hi) { unsigned r; asm volatile("v_cvt_pk_bf16_f32 %0, %1, %2" : "=v"(r) : "v"(lo), "v"(hi)); return r; }

__device__ __forceinline__ void partialSM(f32x16& p0, f32x16& p1, float& m_reg, float& mn, float& alpha, bool first) {
    float pmax = p0[0];
#pragma unroll
    for (int r = 1; r < 16; ++r) pmax = fmaxf(pmax, p0[r]);
#pragma unroll
    for (int r = 0; r < 16; ++r) pmax = fmaxf(pmax, p1[r]);
    { auto rr = __builtin_amdgcn_permlane32_swap(__float_as_uint(pmax), __float_as_uint(pmax), false, false);
      pmax = fmaxf(__uint_as_float(rr[0]), __uint_as_float(rr[1])); }
    if (__builtin_expect(!first && __all(pmax <= THR_L2), 1)) { mn = m_reg; alpha = 1.f; }
    else { const float d = first ? pmax : fmaxf(pmax, 0.f); mn = m_reg + d; alpha = first ? 0.f : __builtin_amdgcn_exp2f(-d); m_reg = mn;
#pragma unroll
        for (int r = 0; r < 16; ++r) p0[r] = p0[r] - d;
#pragma unroll
        for (int r = 0; r < 16; ++r) p1[r] = p1[r] - d; }
#pragma unroll
    for (int r = 0; r < 16; ++r) p0[r] = __builtin_amdgcn_exp2f(p0[r]);
}
__device__ __forceinline__ void finishSM(f32x16& p0, f32x16& p1, float alpha, float& l_reg, bf16x8& pa0, bf16x8& pa1, bf16x8& pa2, bf16x8& pa3) {
#pragma unroll
    for (int r = 0; r < 16; ++r) p1[r] = __builtin_amdgcn_exp2f(p1[r]);
    float ps = 0;
#pragma unroll
    for (int r = 0; r < 16; ++r) ps += p0[r];
#pragma unroll
    for (int r = 0; r < 16; ++r) ps += p1[r];
    { auto rr = __builtin_amdgcn_permlane32_swap(__float_as_uint(ps), __float_as_uint(ps), false, false);
      ps = __uint_as_float(rr[0]) + __uint_as_float(rr[1]); }
    l_reg = l_reg * alpha + ps;
#define PK4(P, BASE, OUT) do { unsigned a0 = cvtpk(P[BASE + 0], P[BASE + 1]), a1 = cvtpk(P[BASE + 2], P[BASE + 3]);   \
    unsigned b0 = cvtpk(P[BASE + 4], P[BASE + 5]), b1 = cvtpk(P[BASE + 6], P[BASE + 7]);                              \
    auto r0 = __builtin_amdgcn_permlane32_swap(a0, b0, false, false); auto r1 = __builtin_amdgcn_permlane32_swap(a1, b1, false, false); \
    u32x4 w = {r0[0], r1[0], r0[1], r1[1]}; OUT = *reinterpret_cast<bf16x8*>(&w); } while (0)
    PK4(p0, 0, pa0); PK4(p0, 8, pa1); PK4(p1, 0, pa2); PK4(p1, 8, pa3);
#undef PK4
}
__device__ __forceinline__ void finishLite(f32x16& p0, f32x16& p1, bf16x8& pa0, bf16x8& pa1, bf16x8& pa2, bf16x8& pa3) {
#define PK4(P, BASE, OUT) do { unsigned a0 = cvtpk(P[BASE + 0], P[BASE + 1]), a1 = cvtpk(P[BASE + 2], P[BASE + 3]);   \
    unsigned b0 = cvtpk(P[BASE + 4], P[BASE + 5]), b1 = cvtpk(P[BASE + 6], P[BASE + 7]);                              \
    auto r0 = __builtin_amdgcn_permlane32_swap(a0, b0, false, false); auto r1 = __builtin_amdgcn_permlane32_swap(a1, b1, false, false); \
    u32x4 w = {r0[0], r1[0], r0[1], r1[1]}; OUT = *reinterpret_cast<bf16x8*>(&w); } while (0)
    PK4(p0, 0, pa0); PK4(p0, 8, pa1); PK4(p1, 0, pa2); PK4(p1, 8, pa3);
#undef PK4
}
template <int DQK>
__device__ __forceinline__ void qkt(f32x16& p0, f32x16& p1, const char* Ks, const bf16x8* qr, int r32, int hi, float negm) {
    constexpr int KROWB = DQK * 2;
#pragma unroll
    for (int r = 0; r < 16; ++r) { p0[r] = negm; p1[r] = negm; }
    const int sw = ((r32 >> 1) & 7) << 4;
#pragma unroll
    for (int d0 = 0; d0 < DQK / 16; ++d0) { const int cb = (d0 * 16 + hi * 8) * 2;
        bf16x8 b0 = *reinterpret_cast<const bf16x8*>(Ks + r32 * KROWB + (cb ^ sw));
        bf16x8 b1 = *reinterpret_cast<const bf16x8*>(Ks + (32 + r32) * KROWB + (cb ^ sw));
        p0 = __builtin_amdgcn_mfma_f32_32x32x16_bf16(b0, qr[d0], p0, 0, 0, 0);
        p1 = __builtin_amdgcn_mfma_f32_32x32x16_bf16(b1, qr[d0], p1, 0, 0, 0); }
}
__device__ __forceinline__ int v_st(int k, int c) { const int kk = (k & ~0xC) | ((k & 4) << 1) | ((k & 8) >> 1); return ((kk >> 3) * 4 + (c >> 5)) * 512 + ((kk & 7) * 32 + (c & 31)) * 2; }
__device__ __forceinline__ int v_rd_base(int lane) { return ((lane & 3) << 3) | (((lane >> 2) & 3) << 6) | (((lane >> 4) & 1) << 5) | (((lane >> 5) & 1) << 8); }
#define TK(j_) ((((j_) + rot) & (SEQ / KVBLK - 1)) * KVBLK)
constexpr int v_rd_off(int d0, int ks, int half) { return d0 * 512 + ks * 4096 + half * 2048; }
template <int OFF> __device__ __forceinline__ s16x4 tr_read(int vb) {
    s16x4 r; asm volatile("ds_read_b64_tr_b16 %0, %1 offset:%2" : "=&v"(r) : "v"(vb), "i"(OFF) : "memory"); return r;
}
struct VFrag { s16x4 l0, h0, l1, h1, l2, h2, l3, h3; };
template <int D0> __device__ __forceinline__ void v_reads(VFrag& f, int vb) {
    f.l0 = tr_read<v_rd_off(D0, 0, 0)>(vb); f.h0 = tr_read<v_rd_off(D0, 0, 1)>(vb); f.l1 = tr_read<v_rd_off(D0, 1, 0)>(vb); f.h1 = tr_read<v_rd_off(D0, 1, 1)>(vb);
    f.l2 = tr_read<v_rd_off(D0, 2, 0)>(vb); f.h2 = tr_read<v_rd_off(D0, 2, 1)>(vb); f.l3 = tr_read<v_rd_off(D0, 3, 0)>(vb); f.h3 = tr_read<v_rd_off(D0, 3, 1)>(vb);
}
__device__ __forceinline__ void pv_mma(f32x16& od, const VFrag& f, bf16x8 pa0, bf16x8 pa1, bf16x8 pa2, bf16x8 pa3) {
#define PK(L, H) (bf16x8){L[0], L[1], L[2], L[3], H[0], H[1], H[2], H[3]}
    od = __builtin_amdgcn_mfma_f32_32x32x16_bf16(pa0, PK(f.l0, f.h0), od, 0, 0, 0);
    od = __builtin_amdgcn_mfma_f32_32x32x16_bf16(pa1, PK(f.l1, f.h1), od, 0, 0, 0);
    od = __builtin_amdgcn_mfma_f32_32x32x16_bf16(pa2, PK(f.l2, f.h2), od, 0, 0, 0);
    od = __builtin_amdgcn_mfma_f32_32x32x16_bf16(pa3, PK(f.l3, f.h3), od, 0, 0, 0);
#undef PK
}
__device__ __forceinline__ void pv_d0(f32x16* o, int vb, bf16x8 pa0, bf16x8 pa1, bf16x8 pa2, bf16x8 pa3) {
    VFrag fa, fb;
    v_reads<0>(fa, vb); v_reads<1>(fb, vb);
    asm volatile("s_waitcnt lgkmcnt(8)" ::: "memory"); SBAR(); pv_mma(o[0], fa, pa0, pa1, pa2, pa3);
    v_reads<2>(fa, vb);
    asm volatile("s_waitcnt lgkmcnt(8)" ::: "memory"); SBAR(); pv_mma(o[1], fb, pa0, pa1, pa2, pa3);
    v_reads<3>(fb, vb);
    asm volatile("s_waitcnt lgkmcnt(8)" ::: "memory"); SBAR(); pv_mma(o[2], fa, pa0, pa1, pa2, pa3);
    asm volatile("s_waitcnt lgkmcnt(0)" ::: "memory"); SBAR(); pv_mma(o[3], fb, pa0, pa1, pa2, pa3);
}

template <int D0> __device__ __forceinline__ void pv_one_s(f32x16& od, int vb, bf16x8 pa0, bf16x8 pa1, bf16x8 pa2, bf16x8 pa3) {
    VFrag f; v_reads<D0>(f, vb);
    asm volatile("s_waitcnt lgkmcnt(0)" ::: "memory"); SBAR();
    pv_mma(od, f, pa0, pa1, pa2, pa3);
}
template <bool DB> __device__ __forceinline__ void pv_sel(f32x16* o, int vb, bf16x8 pa0, bf16x8 pa1, bf16x8 pa2, bf16x8 pa3) {
    if constexpr (DB) pv_d0(o, vb, pa0, pa1, pa2, pa3);
    else { pv_one_s<0>(o[0], vb, pa0, pa1, pa2, pa3); pv_one_s<1>(o[1], vb, pa0, pa1, pa2, pa3); pv_one_s<2>(o[2], vb, pa0, pa1, pa2, pa3); pv_one_s<3>(o[3], vb, pa0, pa1, pa2, pa3); }
}

template <int DQK, int ldq, int ldk, int ldv, int VAR>
__device__ __forceinline__ void attn_core(const bf16_t* __restrict__ Qb, const bf16_t* __restrict__ Kh,
                                          const bf16_t* __restrict__ Vh, char* lds, f32x16 (&o)[4], float (&rli)[16], int rot) {
    constexpr int ND = DQK / 16, KROWB = DQK * 2, SHM_K = 64 * KROWB, NKC = DQK / 64, CPR = DQK / 8;
    const int tid = ltid(), wid = tid >> 6, lane = tid & 63, r32 = lane & 31, hi = lane >> 5;
    char* V_lds = lds + LDS_V; char* K_lds = lds + LDS_K;
    float* ws = (float*)(lds + LDS_WS) + wid * 64; float* li_l = ws; float* al_l = ws + 32;
    float m_reg = 0.f, l_reg = 0;
#pragma unroll
    for (int d = 0; d < 4; ++d) o[d] = f32x16{};
    bf16x8 qr[ND];
    const bf16_t* Qw = Qb + (size_t)(wid * 32 + r32) * ldq + hi * 8;
#pragma unroll
    for (int d0 = 0; d0 < ND; ++d0) qr[d0] = *reinterpret_cast<const bf16x8*>(Qw + d0 * 16);
    const int sr = tid >> 4, sc = (tid & 15) * 8, vst0 = v_st(sr, sc), vst1 = v_st(32 + sr, sc);
    int kg_off[NKC], kl_off[NKC];
#pragma unroll
    for (int i = 0; i < NKC; ++i) { const int cid = tid + 512 * i, kr = cid / CPR, kc = cid % CPR; kg_off[i] = kr * ldk + kc * 8; kl_off[i] = kr * KROWB + ((kc * 16) ^ (((kr >> 1) & 7) << 4)); }
    const int vb0 = (int)(uintptr_t)V_lds + v_rd_base(lane);
    bf16x8 vs0, vs1, ks[NKC];
#define SLOAD(k0) do { if constexpr (VAR == 4) break; vs0 = *reinterpret_cast<const bf16x8*>(&Vh[(size_t)((k0) + sr) * ldv + sc]); vs1 = *reinterpret_cast<const bf16x8*>(&Vh[(size_t)((k0) + 32 + sr) * ldv + sc]); \
    _Pragma("unroll") for (int i_ = 0; i_ < NKC; ++i_) ks[i_] = *reinterpret_cast<const bf16x8*>(&Kh[(size_t)(k0) * ldk + kg_off[i_]]); } while (0)
#define SWRITE(b) do { if constexpr (VAR == 4) break; *(bf16x8*)(V_lds + (b) * SHM_V + vst0) = vs0; *(bf16x8*)(V_lds + (b) * SHM_V + vst1) = vs1; \
    _Pragma("unroll") for (int i_ = 0; i_ < NKC; ++i_) *(bf16x8*)(K_lds + (b) * SHM_K + kl_off[i_]) = ks[i_]; } while (0)
#define SWAIT() asm volatile("s_waitcnt vmcnt(0)" ::: "memory")
#define RESC(a) do { if (__any((a) < 1.f)) { if (hi == 0) al_l[r32] = (a); asm volatile("s_waitcnt lgkmcnt(0)" ::: "memory"); \
    _Pragma("unroll") for (int d = 0; d < 4; ++d) _Pragma("unroll") for (int r = 0; r < 16; ++r) o[d][r] *= al_l[crow(r, hi)]; } } while (0)
    f32x16 pA0, pA1, pB0, pB1; float mnA, mnB, alA, alB; bf16x8 pa0, pa1, pa2, pa3; constexpr int NT = SEQ / KVBLK;
    __syncthreads();
    SLOAD(TK(0)); SWAIT(); SWRITE(0); __syncthreads();
    do { if constexpr (VAR != 3) qkt<DQK>(pA0, pA1, K_lds, qr, r32, hi, -m_reg); else { pA0 = f32x16{}; pA1 = f32x16{}; } } while (0); do { if constexpr (VAR != 1) partialSM(pA0, pA1, m_reg, mnA, alA, true); else { mnA = m_reg; alA = 1.f; } } while (0);
    SLOAD(TK(1));
    SWAIT(); SWRITE(1); __syncthreads();
#pragma unroll 1
    for (int j = 1; j + 1 < NT; j += 2) {
        SBAR(); do { if constexpr (VAR != 3) qkt<DQK>(pB0, pB1, K_lds + SHM_K, qr, r32, hi, -m_reg); else { pB0 = f32x16{}; pB1 = f32x16{}; } } while (0);
        do { if constexpr (VAR != 1) finishSM(pA0, pA1, alA, l_reg, pa0, pa1, pa2, pa3); else finishLite(pA0, pA1, pa0, pa1, pa2, pa3); } while (0); SBAR();
        SLOAD(TK(j + 1)); SBAR();
        do { if constexpr (VAR != 2) pv_d0(o, vb0, pa0, pa1, pa2, pa3); } while (0); do { if constexpr (VAR != 1) partialSM(pB0, pB1, m_reg, mnB, alB, false); else { mnB = m_reg; alB = 1.f; } } while (0);
        __syncthreads(); SWAIT(); SWRITE(0);
        RESC(alB); __syncthreads();
        SBAR(); do { if constexpr (VAR != 3) qkt<DQK>(pA0, pA1, K_lds, qr, r32, hi, -m_reg); else { pA0 = f32x16{}; pA1 = f32x16{}; } } while (0);
        do { if constexpr (VAR != 1) finishSM(pB0, pB1, alB, l_reg, pa0, pa1, pa2, pa3); else finishLite(pB0, pB1, pa0, pa1, pa2, pa3); } while (0); SBAR();
        SLOAD(TK(j + 2)); SBAR();
        do { if constexpr (VAR != 2) pv_d0(o, vb0 + SHM_V, pa0, pa1, pa2, pa3); } while (0); do { if constexpr (VAR != 1) partialSM(pA0, pA1, m_reg, mnA, alA, false); else { mnA = m_reg; alA = 1.f; } } while (0);
        __syncthreads(); SWAIT(); SWRITE(1);
        RESC(alA); __syncthreads();
    }
    SBAR(); do { if constexpr (VAR != 3) qkt<DQK>(pB0, pB1, K_lds + SHM_K, qr, r32, hi, -m_reg); else { pB0 = f32x16{}; pB1 = f32x16{}; } } while (0);
    do { if constexpr (VAR != 1) finishSM(pA0, pA1, alA, l_reg, pa0, pa1, pa2, pa3); else finishLite(pA0, pA1, pa0, pa1, pa2, pa3); } while (0); SBAR();
    do { if constexpr (VAR != 2) pv_d0(o, vb0, pa0, pa1, pa2, pa3); } while (0); do { if constexpr (VAR != 1) partialSM(pB0, pB1, m_reg, mnB, alB, false); else { mnB = m_reg; alB = 1.f; } } while (0);
    __syncthreads(); RESC(alB);
    do { if constexpr (VAR != 1) finishSM(pB0, pB1, alB, l_reg, pa0, pa1, pa2, pa3); else finishLite(pB0, pB1, pa0, pa1, pa2, pa3); } while (0); SBAR();
    do { if constexpr (VAR != 2) pv_d0(o, vb0 + SHM_V, pa0, pa1, pa2, pa3); } while (0);
    if (hi == 0) li_l[r32] = l_reg; asm volatile("s_waitcnt lgkmcnt(0)" ::: "memory");
#pragma unroll
    for (int r = 0; r < 16; ++r) rli[r] = __builtin_amdgcn_rcpf(li_l[crow(r, hi)]);
#undef SLOAD
#undef SWRITE
#undef SWAIT
#undef RESC
}

template <int DQK, int ldq, int ldk, int ldv, int VAR, bool MQA>
__device__ __forceinline__ void attn_core1(const bf16_t* __restrict__ Qb, const bf16_t* __restrict__ Kh,
                                           const bf16_t* __restrict__ Vh, char* lds, f32x16 (&o)[4], float (&rli)[16], int rot) {
    constexpr int ND = DQK / 16, KROWB = DQK * 2, SHM_K = 64 * KROWB, NKC = DQK / 64, CPR = DQK / 8;
    const int tid = ltid(), wid = tid >> 6, lane = tid & 63, r32 = lane & 31, hi = lane >> 5;
    char* V_lds = lds + LDS_V; char* K_lds = lds + LDS_K;
    float* ws = (float*)(lds + LDS_WS) + wid * 64; float* li_l = ws; float* al_l = ws + 32;
    float m_reg = 0.f, l_reg = 0;
#pragma unroll
    for (int d = 0; d < 4; ++d) o[d] = f32x16{};
    bf16x8 qr[ND];
    const bf16_t* Qw = MQA ? Qb + (size_t)((wid & 1) * 32 + r32) * ldq + (wid >> 1) * DQK + hi * 8 : Qb + (size_t)(wid * 32 + r32) * ldq + hi * 8;
#pragma unroll
    for (int d0 = 0; d0 < ND; ++d0) qr[d0] = *reinterpret_cast<const bf16x8*>(Qw + d0 * 16);
    const int sr = tid >> 4, sc = (tid & 15) * 8, vst0 = v_st(sr, sc), vst1 = v_st(32 + sr, sc);
    int kg_off[NKC], kl_off[NKC];
#pragma unroll
    for (int i = 0; i < NKC; ++i) { const int cid = tid + 512 * i, kr = cid / CPR, kc = cid % CPR; kg_off[i] = kr * ldk + kc * 8; kl_off[i] = kr * KROWB + ((kc * 16) ^ (((kr >> 1) & 7) << 4)); }
    const int vb0 = (int)(uintptr_t)V_lds + v_rd_base(lane);
    bf16x8 vs0, vs1, ks[NKC];
#define SLOAD(k0) do { if constexpr (VAR == 4) break; vs0 = *reinterpret_cast<const bf16x8*>(&Vh[(size_t)((k0) + sr) * ldv + sc]); vs1 = *reinterpret_cast<const bf16x8*>(&Vh[(size_t)((k0) + 32 + sr) * ldv + sc]); \
    _Pragma("unroll") for (int i_ = 0; i_ < NKC; ++i_) ks[i_] = *reinterpret_cast<const bf16x8*>(&Kh[(size_t)(k0) * ldk + kg_off[i_]]); } while (0)
#define SWRITE(b) do { if constexpr (VAR == 4) break; *(bf16x8*)(V_lds + (b) * SHM_V + vst0) = vs0; *(bf16x8*)(V_lds + (b) * SHM_V + vst1) = vs1; \
    _Pragma("unroll") for (int i_ = 0; i_ < NKC; ++i_) *(bf16x8*)(K_lds + (b) * SHM_K + kl_off[i_]) = ks[i_]; } while (0)
#define SWAIT() asm volatile("s_waitcnt vmcnt(0)" ::: "memory")
#define RESC(a) do { if (__any((a) < 1.f)) { if (hi == 0) al_l[r32] = (a); asm volatile("s_waitcnt lgkmcnt(0)" ::: "memory"); \
    _Pragma("unroll") for (int d = 0; d < 4; ++d) _Pragma("unroll") for (int r = 0; r < 16; ++r) o[d][r] *= al_l[crow(r, hi)]; } } while (0)
    f32x16 p0, p1; float mn, al; bf16x8 pa0, pa1, pa2, pa3; constexpr int NT = SEQ / KVBLK;
    __syncthreads();
    SLOAD(TK(0)); SWAIT(); SWRITE(0); SLOAD(TK(1)); __syncthreads();
#pragma unroll 1
    for (int j = 0; j < NT; ++j) {
        const int cur = j & 1;
        SBAR(); do { if constexpr (VAR != 3) qkt<DQK>(p0, p1, K_lds + cur * SHM_K, qr, r32, hi, -m_reg); else { p0 = f32x16{}; p1 = f32x16{}; } } while (0);
        if (j + 1 < NT) { SWAIT(); SWRITE(cur ^ 1); }
        if (j + 2 < NT) SLOAD(TK(j + 2));
        SBAR();
        do { if constexpr (VAR != 1) partialSM(p0, p1, m_reg, mn, al, j == 0); else { mn = m_reg; al = 1.f; } } while (0); RESC(al);
        do { if constexpr (VAR != 1) finishSM(p0, p1, al, l_reg, pa0, pa1, pa2, pa3); else finishLite(p0, p1, pa0, pa1, pa2, pa3); } while (0); SBAR();
        do { if constexpr (VAR != 2) pv_d0(o, vb0 + cur * SHM_V, pa0, pa1, pa2, pa3); } while (0);
        __syncthreads();
    }
    if (hi == 0) li_l[r32] = l_reg; asm volatile("s_waitcnt lgkmcnt(0)" ::: "memory");
#pragma unroll
    for (int r = 0; r < 16; ++r) rli[r] = __builtin_amdgcn_rcpf(li_l[crow(r, hi)]);
#undef SLOAD
#undef SWRITE
#undef SWAIT
#undef RESC
}

__device__ __forceinline__ bf16_t f2bf(float x) { return (bf16_t)(cvtpk(x, x) & 0xffffu); }
}

struct AttnPtrs { const bf16_t *Qd, *Kd, *Vd, *Qm, *Km, *Vm; bf16_t* AO; float* stash; const float* subln; float lam_init; };

template <int VAR> __device__ __forceinline__ void mla_unit(const AttnPtrs& P, int seq, int qb64, char* lds) {
    const int tid = ltid(), wid = tid >> 6, lane = tid & 63, r32 = lane & 31, hi = lane >> 5;
    const size_t rowq = (size_t)seq * SEQ + qb64 * 64, rowk = (size_t)seq * SEQ;
    att::f32x16 o[4]; float rli[16];
    att::attn_core1<192, 768, 192, 192, VAR, true>(P.Qm + rowq * 768, P.Km + rowk * 192, P.Km + rowk * 192, lds, o, rli, (qb64 & 7) * 4);
    bf16_t* Ow = P.AO + (rowq + (wid & 1) * 32 + 4 * hi) * 1024 + 512 + (wid >> 1) * 128 + r32;
#pragma unroll
    for (int r = 0; r < 16; ++r) { bf16_t* pr = Ow + ((r & 3) + 8 * (r >> 2)) * 1024; asm volatile("" : "+v"(pr));
#pragma unroll
        for (int d0 = 0; d0 < 4; ++d0) pr[d0 * 32] = att::f2bf(o[d0][r] * rli[r]); }
}

template <int VAR> __device__ __forceinline__ void diff_unit(const AttnPtrs& P, int seq, int h, int qb, float lam, char* lds) {
    const int tid = ltid(), wid = tid >> 6, lane = tid & 63, r32 = lane & 31, hi = lane >> 5;
    const size_t rowq = (size_t)seq * SEQ + qb * 256, rowk = (size_t)seq * SEQ;
    float* st = P.stash + (size_t)blockIdx.x * 32768 + tid * 64;
    att::f32x16 o[4]; float rli[16];
    att::attn_core1<64, 512, 512, 512, VAR, false>(P.Qd + rowq * 512 + (2 * h) * 64, P.Kd + rowk * 512 + (2 * h) * 64, P.Vd + rowk * 512 + h * 128, lds, o, rli, qb * 4);
#pragma unroll
    for (int d0 = 0; d0 < 4; ++d0)
#pragma unroll
        for (int r = 0; r < 16; r += 4) *(f32x4*)(st + d0 * 16 + r) = (f32x4){o[d0][r] * rli[r], o[d0][r + 1] * rli[r + 1], o[d0][r + 2] * rli[r + 2], o[d0][r + 3] * rli[r + 3]};
    att::attn_core1<64, 512, 512, 512, VAR, false>(P.Qd + rowq * 512 + (2 * h + 1) * 64, P.Kd + rowk * 512 + (2 * h + 1) * 64, P.Vd + rowk * 512 + h * 128, lds, o, rli, qb * 4);
    float g[4];
#pragma unroll
    for (int d0 = 0; d0 < 4; ++d0) g[d0] = P.subln[d0 * 32 + r32] * (1.0f - P.lam_init);
    bf16_t* Ow = P.AO + (rowq + wid * 32 + 4 * hi) * 1024 + h * 128 + r32;
#pragma unroll
    for (int r = 0; r < 16; ++r) {
        float y[4], s = 0.f;
#pragma unroll
        for (int d0 = 0; d0 < 4; ++d0) { y[d0] = st[d0 * 16 + r] - lam * (o[d0][r] * rli[r]); s += y[d0] * y[d0]; }
        s += __shfl_xor(s, 1); s += __shfl_xor(s, 2); s += __shfl_xor(s, 4); s += __shfl_xor(s, 8); s += __shfl_xor(s, 16);
        const float rn = __builtin_amdgcn_rsqf(s * (1.0f / 128.0f) + EPS);
        bf16_t* pr = Ow + ((r & 3) + 8 * (r >> 2)) * 1024; asm volatile("" : "+v"(pr));
#pragma unroll
        for (int d0 = 0; d0 < 4; ++d0) pr[d0 * 32] = att::f2bf(y[d0] * rn * g[d0]);
    }
}

enum { W_IN = 0, W_Q, W_KV, W_O, W_GU, W_D };
__device__ __forceinline__ int map_in(int p) {
    const int pn = p >> 8, bj = (p >> 7) & 1, wc = (p >> 5) & 3, i = p & 31;
    if (pn < 4) return pn * 256 + wc * 64 + bj * 32 + i;
    if (pn < 7) return p;
    if (bj == 0) return wc < 3 ? 1792 + wc * 32 + i : 1920 + i;
    return wc == 0 ? 1888 + i : (wc == 3 ? 1952 + i : -1);
}
__device__ __forceinline__ int map_q(int p) {
    const int pn = p >> 8, bj = (p >> 7) & 1, wc = (p >> 5) & 3, i = p & 31;
    if (pn < 2) return (2 * pn + bj) * 192 + wc * 32 + i;
    return wc * 192 + 128 + bj * 32 + i;
}
__device__ __forceinline__ void prep_item(const float* W, const float* W2, const float* gain, int K, int ldw, int which, bf16_t* dst, int item, int nkb, float* tile) {
    const int tid = ltid(), pb = item / nkb, kb = item % nkb, p0 = pb * 64, k0 = kb * 64;
    const int pp = tid & 63, p = p0 + pp; int lc = p; const float* src = W;
    if (which == W_IN) lc = map_in(p);
    else if (which == W_Q) lc = map_q(p);
    else if (which == W_GU) { lc = (p >> 8) * 128 + (p & 127); if ((p >> 7) & 1) src = W2; }
#pragma unroll
    for (int i = 0; i < 8; ++i) { const int kk = (tid >> 6) + 8 * i; float v = 0.f;
        if (lc >= 0) { v = src[(size_t)(k0 + kk) * ldw + lc]; if (gain) v *= gain[k0 + kk]; }
        tile[kk * 65 + pp] = v; }
    __syncthreads();
    const int pr = tid >> 3, kc = (tid & 7) * 8; const float* s = tile + kc * 65 + pr;
    u32x4 o; o.x = cvt_pk_bf16(s[0], s[65]); o.y = cvt_pk_bf16(s[130], s[195]); o.z = cvt_pk_bf16(s[260], s[325]); o.w = cvt_pk_bf16(s[390], s[455]);
    *(u32x4*)(dst + (size_t)(p0 + pr) * K + k0 + kc) = o;
    __syncthreads();
}

__device__ __forceinline__ void prep_qkv_item(const float* Wq, const float* gq, const float* Wkv, const float* gkv, bf16_t* dst, int item, float* tile) {
    const int tid = ltid(), pb = item / 6, kb = item % 6, p0 = pb * 64, k0 = kb * 64;
    const int pp = tid & 63, p = p0 + pp;
    const bool isq = p0 < 768; const bool live = isq ? (kb < 4) : (kb >= 4);
    const float* src = isq ? Wq : Wkv; const float* gain = isq ? gq : gkv; const int ldw = isq ? 768 : 1024, kof = isq ? 0 : 256, lc = isq ? map_q(p) : p - 768;
#pragma unroll
    for (int i = 0; i < 8; ++i) { const int kk = (tid >> 6) + 8 * i; float v = 0.f;
        if (live) v = src[(size_t)(k0 + kk - kof) * ldw + lc] * gain[k0 + kk - kof];
        tile[kk * 65 + pp] = v; }
    __syncthreads();
    const int pr = tid >> 3, kc = (tid & 7) * 8; const float* t = tile + kc * 65 + pr;
    u32x4 o; o.x = cvt_pk_bf16(t[0], t[65]); o.y = cvt_pk_bf16(t[130], t[195]); o.z = cvt_pk_bf16(t[260], t[325]); o.w = cvt_pk_bf16(t[390], t[455]);
    *(u32x4*)(dst + (size_t)(p0 + pr) * 384 + k0 + kc) = o;
    __syncthreads();
}

__device__ __forceinline__ void absorb_qk(const float* Wqb_all, const float* gq_all, const float* Wkvb_all, const float* gkv_all, unsigned char* ws, int t) {
    const int kb = t & 31, j = (t >> 5) & 127, h = (t >> 12) & 3, l = t >> 14;
    const float* Wqb = Wqb_all + (size_t)l * 256 * 768 + (size_t)(8 * kb) * 768 + 192 * h;
    const float* Wk = Wkvb_all + (size_t)l * 128 * 1024 + (size_t)j * 1024 + 256 * h;
    float acc[8];
#pragma unroll
    for (int kk = 0; kk < 8; ++kk) acc[kk] = 0.f;
#pragma unroll 1
    for (int i = 0; i < 128; i += 4) {
        const f32x4 b = ld4g(Wk + i);
#pragma unroll
        for (int kk = 0; kk < 8; ++kk) { const f32x4 a = ld4g(Wqb + (size_t)kk * 768 + i); acc[kk] += (a[0] * b[0] + a[1] * b[1]) + (a[2] * b[2] + a[3] * b[3]); }
    }
    const float gk = gkv_all[l * 128 + j]; const float* gq = gq_all + l * 256 + 8 * kb;
    bf16_t* dst = (bf16_t*)(ws + WS_W + l * W_LAYER + OW_Q) + (size_t)((h >> 1) * 256 + (h & 1) * 128 + j) * 256 + 8 * kb;
    u32x4 o; o.x = cvt_pk_bf16(acc[0] * gk * gq[0], acc[1] * gk * gq[1]); o.y = cvt_pk_bf16(acc[2] * gk * gq[2], acc[3] * gk * gq[3]);
    o.z = cvt_pk_bf16(acc[4] * gk * gq[4], acc[5] * gk * gq[5]); o.w = cvt_pk_bf16(acc[6] * gk * gq[6], acc[7] * gk * gq[7]);
    *(GAS u32x4*)dst = o;
}
__device__ __forceinline__ void absorb_vo(const float* Wkvb_all, const float* gkv_all, const float* Wo_all, unsigned char* ws, int t) {
    const int n = t & 1023, jb = (t >> 10) & 15, h = (t >> 14) & 3, l = t >> 16;
    const float* Wv = Wkvb_all + (size_t)l * 128 * 1024 + (size_t)(8 * jb) * 1024 + 256 * h + 128;
    const float* Wo = Wo_all + (size_t)l * DM * DM + (size_t)(512 + 128 * h) * DM + n;
    float acc[8];
#pragma unroll
    for (int jj = 0; jj < 8; ++jj) acc[jj] = 0.f;
#pragma unroll 1
    for (int i = 0; i < 128; i += 4) {
        const float b0 = ld1g(Wo + (size_t)i * DM), b1 = ld1g(Wo + (size_t)(i + 1) * DM), b2 = ld1g(Wo + (size_t)(i + 2) * DM), b3 = ld1g(Wo + (size_t)(i + 3) * DM);
#pragma unroll
        for (int jj = 0; jj < 8; ++jj) { const f32x4 a = ld4g(Wv + (size_t)jj * 1024 + i); acc[jj] += (a[0] * b0 + a[1] * b1) + (a[2] * b2 + a[3] * b3); }
    }
    const float* gk = gkv_all + l * 128 + 8 * jb;
    bf16_t* dst = (bf16_t*)(ws + WS_W + l * W_LAYER + OW_O) + (size_t)n * DM + 512 + 128 * h + 8 * jb;
    u32x4 o; o.x = cvt_pk_bf16(acc[0] * gk[0], acc[1] * gk[1]); o.y = cvt_pk_bf16(acc[2] * gk[2], acc[3] * gk[3]);
    o.z = cvt_pk_bf16(acc[4] * gk[4], acc[5] * gk[5]); o.w = cvt_pk_bf16(acc[6] * gk[6], acc[7] * gk[7]);
    *(GAS u32x4*)dst = o;
}
__device__ __forceinline__ float wave_sum(float v) {
#pragma unroll
    for (int o = 1; o < 64; o <<= 1) v += __shfl_xor(v, o);
    return v;
}


#define LAS __attribute__((address_space(3)))
#define XB_TMO      128
#define XB_XCNT(j)  (256  + 64 * (j))
#define XB_XSUB(j)  (1280 + 64 * (j))
#define XB_XGEN(j)  (2304 + 64 * (j))
#define XB_TOP      3328
#define XB_TOPGEN   3392
#define XCD_BAR_WORDS 3456
#define XB_SPIN_CAP (1u << 18)

__device__ __forceinline__ unsigned xb_ld(unsigned* p)              { return __hip_atomic_load(p, __ATOMIC_RELAXED, __HIP_MEMORY_SCOPE_AGENT); }
__device__ __forceinline__ unsigned xb_add(unsigned* p, unsigned v) { return __hip_atomic_fetch_add(p, v, __ATOMIC_RELAXED, __HIP_MEMORY_SCOPE_AGENT); }
__device__ __forceinline__ unsigned xb_xcc_id() { return (unsigned)__builtin_amdgcn_s_getreg((3 << 11) | 20) & 0xFu; }
#define XB_SPIN(cond, bar) do { unsigned _sp = 0; while (cond) { __builtin_amdgcn_s_sleep(1); \
    if ((++_sp & 255u) == 0u) { if (xb_ld(&(bar)[XB_TMO])) break; if (_sp > XB_SPIN_CAP) { atomicAdd(&(bar)[XB_TMO], 1u); break; } } } } while (0)

struct XcdBarrier {
    unsigned* bar; unsigned x;
    volatile LAS unsigned* st;
};

__device__ __forceinline__ XcdBarrier xcd_barrier_post(unsigned* bar, volatile LAS unsigned* st) {
    XcdBarrier b; b.bar = bar; b.x = xb_xcc_id(); b.st = st;
    if (ltid() == 0) (void)xb_add(&bar[XB_XCNT(b.x)], 1u);
    return b;
}
__device__ __forceinline__ void xcd_barrier_complete(unsigned* bar, unsigned x, unsigned& nloc, unsigned& nx) {
    const unsigned G = gridDim.x * gridDim.y * gridDim.z;
    unsigned sum, cnt, mine, sp = 0u;
    for (;;) {
        sum = 0u; cnt = 0u; mine = 0u;
#pragma unroll
        for (unsigned j = 0; j < 16; ++j) { const unsigned c = xb_ld(&bar[XB_XCNT(j)]); sum += c; cnt += (c > 0u) ? 1u : 0u; mine = (j == x) ? c : mine; }
        if (sum == G) break;
        __builtin_amdgcn_s_sleep(1);
        if ((++sp & 255u) == 0u) { if (xb_ld(&bar[XB_TMO])) break; if (sp > XB_SPIN_CAP) { atomicAdd(&bar[XB_TMO], 1u); break; } }
    }
    nloc = mine > 0u ? mine : 1u; nx = cnt > 0u ? cnt : 1u;
}

__device__ __forceinline__ void xcd_barrier(const XcdBarrier& b) {
    asm volatile("s_waitcnt vmcnt(0)" ::: "memory");
    __syncthreads();
    if (ltid() == 0) {
        unsigned* bar = b.bar;
        __builtin_amdgcn_s_waitcnt(0);
        unsigned nloc = b.st[0], nx = b.st[1];
        if (nloc == 0u) { xcd_barrier_complete(bar, b.x, nloc, nx); b.st[0] = nloc; b.st[1] = nx; }
        const unsigned old = xb_add(&bar[XB_XSUB(b.x)], 1u);
        const unsigned gen = old / nloc;
        if (old + 1u == (gen + 1u) * nloc) {
            __builtin_amdgcn_fence(__ATOMIC_RELEASE, "agent");
            asm volatile("s_waitcnt vmcnt(0)" ::: "memory");
            const unsigned og = xb_add(&bar[XB_TOP], 1u);
            const unsigned tg = og / nx;
            if (og + 1u == (tg + 1u) * nx) xb_add(&bar[XB_TOPGEN], 1u);
            else XB_SPIN(xb_ld(&bar[XB_TOPGEN]) == tg, bar);
            __builtin_amdgcn_fence(__ATOMIC_ACQUIRE, "agent");
            xb_add(&bar[XB_XGEN(b.x)], 1u);
            asm volatile("s_waitcnt vmcnt(0)" ::: "memory");
        } else {
            XB_SPIN(xb_ld(&bar[XB_XGEN(b.x)]) == gen, bar);
            __builtin_amdgcn_fence(__ATOMIC_ACQUIRE, "agent");
            asm volatile("s_waitcnt vmcnt(0)" ::: "memory");
        }
    }
    __syncthreads();
}
struct Args { const float* in[19]; float* out; unsigned char* ws; int ph_lo, ph_hi; };
constexpr int PPL = (REPK == -2) ? 6 : 7, PPC = 2 + DEPTH * PPL, NPHASE = 1 + NCH * PPC;

__global__ void __launch_bounds__(NTHR, 2) fwd_kernel(Args args) {
    extern __shared__ __attribute__((aligned(16))) unsigned char lds[];
    PG8_LAS unsigned char* lds3 = (PG8_LAS unsigned char*)lds;
    const int G = gridDim.x, bx = blockIdx.x;
    const int vcu = (G % 8 == 0) ? (bx % 8) * (G / 8) + bx / 8 : bx;
    volatile LAS unsigned* bst = (volatile LAS unsigned*)(lds3 + 131072 + 1024);
    { const int t0 = ltid(); if (t0 < 2) bst[t0] = 0u; }
    __syncthreads();
    (void)xcd_barrier_post((unsigned*)(args.ws + WS_BAR), bst);
    for (int ph = args.ph_lo; ph < args.ph_hi; ++ph) {
    unsigned char* ws = args.ws; asm volatile("" : "+s"(ws));
    const float* rope = (const float*)(ws + WS_ROPE);
    u64* ssq_all = (u64*)(ws + WS_SSQ);
    unsigned char* dob = (unsigned char*)args.out; asm volatile("" : "+s"(dob));
    bf16_t* XB = (bf16_t*)(ws + WS_XB); bf16_t* AO = (bf16_t*)(dob + DO_AO);
    bf16_t* Qd = (bf16_t*)(dob + DO_QD); bf16_t* Kd = (bf16_t*)(dob + DO_KD); bf16_t* Vd = (bf16_t*)(ws + WS_VD);
    bf16_t* CQ = (bf16_t*)(ws + WS_CQ); bf16_t* CKV = nullptr;
    bf16_t* Qm = (bf16_t*)(ws + WS_QM); bf16_t* Km = (bf16_t*)(ws + WS_KM); bf16_t* Vm = (bf16_t*)(ws + WS_VM);
    bf16_t* ACT = (bf16_t*)(ws + WS_ACT);
    {
        if (ph == 0 && (PHMASK & 1)) {
            float* tile = (float*)lds;
            constexpr int nIn = 32 * 16, nQR = 16, nO = 16 * 8, nGU = 88 * 16, nD = 16 * 44, nL = nIn + nQR + nO + nGU + nD;
#pragma unroll 1
            for (int it = bx; it < DEPTH * nL; it += G) {
                const int l = it / nL; int r = it % nL; unsigned char* wl = ws + WS_W + l * W_LAYER;
                if (r < nIn) { prep_item(args.in[3] + (size_t)l * DM * IN_COLS, nullptr, args.in[2] + l * DM, DM, IN_COLS, W_IN, (bf16_t*)(wl + OW_IN), r, 16, tile); continue; } r -= nIn;
                if (r < nQR) { prep_item(args.in[10] + (size_t)l * 256 * 768, nullptr, args.in[9] + l * 256, 256, 768, W_Q, (bf16_t*)(wl + OW_Q), 32 + r, 4, tile); continue; } r -= nQR;
                if (r < nO) { prep_item(args.in[13] + (size_t)l * DM * DM, nullptr, nullptr, DM, DM, W_O, (bf16_t*)(wl + OW_O), (r >> 3) * 16 + (r & 7), 16, tile); continue; } r -= nO;
                if (r < nGU) { prep_item(args.in[15] + (size_t)l * DM * DFF, args.in[16] + (size_t)l * DM * DFF, args.in[14] + l * DM, DM, DFF, W_GU, (bf16_t*)(wl + OW_GU), r, 16, tile); continue; } r -= nGU;
                prep_item(args.in[17] + (size_t)l * DFF * DM, nullptr, nullptr, DFF, DM, W_D, (bf16_t*)(wl + OW_D), r, 44, tile);
            }
#pragma unroll 1
            for (int t = bx * NTHR + ltid(); t < DEPTH * 16384; t += G * NTHR) { asm volatile("" : "+v"(t)); absorb_qk(args.in[10], args.in[9], args.in[12], args.in[11], ws, t); }
#pragma unroll 1
            for (int t = bx * NTHR + ltid(); t < DEPTH * 65536; t += G * NTHR) { asm volatile("" : "+v"(t)); absorb_vo(args.in[12], args.in[11], args.in[13], ws, t); }
#pragma unroll 1
            for (int e = bx * NTHR + ltid(); e < SEQ * 32; e += G * NTHR) { asm volatile("" : "+v"(e));
                const int pos = e >> 5, i = e & 31;
                const float inv = __builtin_amdgcn_exp2f(-(float)i * (13.287712379549449f / 32.0f));
                float t = ((float)pos * inv) * 0.15915494309189535f; t -= floorf(t);
                float* rt = (float*)(ws + WS_ROPE);
                rt[pos * 64 + i] = __builtin_amdgcn_cosf(t); rt[pos * 64 + 32 + i] = __builtin_amdgcn_sinf(t);
            }
#pragma unroll 1
            for (int e = bx * NTHR + ltid(); e < 8 * MTOT; e += G * NTHR) { asm volatile("" : "+v"(e)); ssq_all[MTOT + e] = 0ull; }
        } else {
            const int c = (ph - 1) / PPC, q = (ph - 1) % PPC;
            const int rows = MTOT, rbase = 0, nseq = rows / SEQ; (void)c;
            const float* xin0 = args.in[0]; const float* xin1 = args.in[1] - (size_t)ROWS0 * DM;
            float* outc = args.out + (size_t)rbase * DM;
            if (q == PPC - 1) {
                const int tq = ltid(), lane = tq & 63, wave = __builtin_amdgcn_readfirstlane(tq >> 6);
                const float* gf = args.in[18];
                f32x4 gg[4];
#pragma unroll
                for (int j = 0; j < 4; ++j) gg[j] = ld4g(gf + 4 * lane + 256 * j);
                const u64* ssqf = ssq_all + (size_t)8 * MTOT + rbase;
                const int NGW = G * NWAVES;
                int row = vcu * NWAVES + wave;
#pragma unroll 1
                for (; row < rows; row += 4 * NGW) {
                    unsigned long long v[4][4]; float rs[4];
#pragma unroll
                    for (int b = 0; b < 4; ++b) { const int rr = (row + b * NGW < rows) ? row + b * NGW : row;
                        rs[b] = __builtin_amdgcn_rsqf(ldssq(ssqf + rr) * (1.0f / 1024.0f) + EPS);
                        const GAS unsigned long long* xr = (const GAS unsigned long long*)(XB + (size_t)rr * DM) + lane;
#pragma unroll
                        for (int j = 0; j < 4; ++j) v[b][j] = xr[64 * j]; }
#pragma unroll
                    for (int b = 0; b < 4; ++b) { const int rr = row + b * NGW; if (rr < rows) {
                        float* orow = outc + (size_t)rr * DM + 4 * lane;
#pragma unroll
                        for (int j = 0; j < 4; ++j) { const unsigned lo = (unsigned)v[b][j], hi = (unsigned)(v[b][j] >> 32);
                            const f32x4 x = {__uint_as_float(lo << 16), __uint_as_float(lo & 0xffff0000u), __uint_as_float(hi << 16), __uint_as_float(hi & 0xffff0000u)};
                            st4g(orow + 256 * j, x * rs[b] * gg[j]); } } }
                }
            } else if (q == 0 && (PHMASK & 4)) {
                const int tq = ltid(), lane = tq & 63, wave = __builtin_amdgcn_readfirstlane(tq >> 6);
                u64* ssq0 = ssq_all + rbase;
                const int NGW = G * NWAVES;
                int row = vcu * NWAVES + wave;
#pragma unroll 1
                for (; row + 3 * NGW < rows; row += 4 * NGW) {
                    f32x4 v[4][4];
#pragma unroll
                    for (int b = 0; b < 4; ++b) { const int rq = row + b * NGW; const f32x4* xr = (const f32x4*)((rq < ROWS0 ? xin0 : xin1) + (size_t)rq * DM) + lane;
#pragma unroll
                        for (int j = 0; j < 4; ++j) v[b][j] = xr[64 * j]; }
#pragma unroll
                    for (int b = 0; b < 4; ++b) { const int rr = row + b * NGW;
                        float sm = 0.f; unsigned long long* o8 = (unsigned long long*)(XB + (size_t)rr * DM) + lane;
#pragma unroll
                        for (int j = 0; j < 4; ++j) { const f32x4 w = v[b][j]; sm += (w[0] * w[0] + w[1] * w[1]) + (w[2] * w[2] + w[3] * w[3]);
                            o8[64 * j] = (unsigned long long)cvt_pk_bf16(w[0], w[1]) | ((unsigned long long)cvt_pk_bf16(w[2], w[3]) << 32); }
                        sm = wave_sum(sm);
                        if (lane == 0) ssq0[rr] = (u64)(sm * SSQ_FX); }
                }
#pragma unroll 1
                for (; row < rows; row += NGW) {
                    const f32x4* xr = (const f32x4*)((row < ROWS0 ? xin0 : xin1) + (size_t)row * DM) + lane; float sm = 0.f;
                    unsigned long long* o8 = (unsigned long long*)(XB + (size_t)row * DM) + lane;
#pragma unroll
                    for (int j = 0; j < 4; ++j) { const f32x4 w = xr[64 * j]; sm += (w[0] * w[0] + w[1] * w[1]) + (w[2] * w[2] + w[3] * w[3]);
                        o8[64 * j] = (unsigned long long)cvt_pk_bf16(w[0], w[1]) | ((unsigned long long)cvt_pk_bf16(w[2], w[3]) << 32); }
                    sm = wave_sum(sm);
                    if (lane == 0) ssq0[row] = (u64)(sm * SSQ_FX);
                }
            } else {
                const int l = (q - 1) / PPL, k0 = (q - 1) % PPL, k = (k0 < 6) ? k0 : REPK;
                unsigned char* wl = ws + WS_W + l * W_LAYER;
                const u64* ssq_in = (l == 0) ? ssq_all + rbase : ssq_all + (size_t)(1 + 3) * MTOT + rbase;
                u64* ssq_q = ssq_all + (size_t)(1 + 4 * l + 0) * MTOT + rbase;
                u64* ssq_kv = ssq_all + (size_t)(1 + 4 * l + 1) * MTOT + rbase;
                u64* ssq_ffn = ssq_all + (size_t)(1 + 4 * l + 2) * MTOT + rbase;
                u64* ssq_x = ssq_all + (size_t)(1 + 4 * l + 3) * MTOT + rbase;
                if (k == 0 && (PHMASK & 8)) {
                    pg8::Gemm g{XB, (const bf16_t*)(wl + OW_IN), rows, IN_PHYS, DM}; pg8::StaticOrder S; S.init(rows, IN_PHYS, G, bx);
                    EpiIn E{Qd, Kd, Vd, CQ, CKV, Km, ssq_in, ssq_q, ssq_kv, rope};
                    pg8::gemm_phase<EpiIn, pg8::StaticOrder, PG8_ALIGN, PG8_SP2>(lds3, g, S, E);
                } else if (k == 1 && (PHMASK & 16)) {
                    {
                        const int tq = ltid(), lane = tq & 63, wave = __builtin_amdgcn_readfirstlane(tq >> 6); const int NGW = G * NWAVES;
#pragma unroll 1
                        for (int row = vcu * NWAVES + wave; row < rows; row += 4 * NGW) {
                            unsigned v[4]; float rs[4];
#pragma unroll
                            for (int b = 0; b < 4; ++b) { const int rr = (row + b * NGW < rows) ? row + b * NGW : row;
                                rs[b] = __builtin_amdgcn_rsqf(ldssq(ssq_kv + rr) * (1.0f / 128.0f) + EPS);
                                v[b] = *((const GAS unsigned*)(Km + (size_t)rr * 192) + lane); }
#pragma unroll
                            for (int b = 0; b < 4; ++b) { const int rr = row + b * NGW; if (rr < rows)
                                *((GAS unsigned*)(Km + (size_t)rr * 192) + lane) = cvt_pk_bf16(__uint_as_float(v[b] << 16) * rs[b], __uint_as_float(v[b] & 0xffff0000u) * rs[b]); }
                        }
                    }
                    pg8::Gemm g{CQ, (const bf16_t*)(wl + OW_Q), rows, 768, 256}; pg8::StaticOrder S; S.init(rows, 768, G, bx);
                    EpiQKV E{Qm, Km, Vm, ssq_q, ssq_kv, rope};
                    pg8::gemm_phase<EpiQKV, pg8::StaticOrder, PG8_ALIGN, PG8_SP2>(lds3, g, S, E);
                } else if (k == 2 && (PHMASK & 32)) {
                    const float lam_init = (l == 0) ? 0.2f : 0.35550906759096926f;
                    float s1 = 0.f, s2 = 0.f;
                    for (int i = 0; i < 64; ++i) { s1 += args.in[4][l * 64 + i] * args.in[5][l * 64 + i]; s2 += args.in[6][l * 64 + i] * args.in[7][l * 64 + i]; }
                    const float lam = __expf(s1) - __expf(s2) + lam_init;
                    AttnPtrs P{Qd, Kd, Vd, Qm, Km, Vm, AO, (float*)(ws + WS_STASH), args.in[8] + l * 128, lam_init};
                    const int nU = nseq * 32;
                    for (int u = vcu; u < 2 * nU; u += G) {
                        const int kind = u / nU, v = u % nU, qb = v & 7, h = (v >> 3) & 3, seq = v >> 5;
#if defined(ABL)
                        if (k0 >= 6) { if (kind == 0) mla_unit<ABL>(P, v >> 5, v & 31, (char*)lds); else diff_unit<ABL>(P, seq, h, qb, lam, (char*)lds); } else
#endif
                        { if (kind == 0) { if (PHMASK & 1024) mla_unit<0>(P, v >> 5, v & 31, (char*)lds); } else { if (PHMASK & 2048) diff_unit<0>(P, seq, h, qb, lam, (char*)lds); } }
                    }
                    __syncthreads();
                } else if (k == 3 && (PHMASK & 64)) {
                    pg8::Gemm g{AO, (const bf16_t*)(wl + OW_O), rows, DM, DM}; pg8::StaticOrder S; S.init(rows, DM, G, bx);
                    EpiRes E{XB, ssq_ffn};
                    pg8::gemm_phase<EpiRes, pg8::StaticOrder, PG8_ALIGN, PG8_SP2>(lds3, g, S, E);
                } else if (k == 4 && (PHMASK & 128)) {
                    pg8::Gemm g{XB, (const bf16_t*)(wl + OW_GU), rows, GU_PHYS, DM}; pg8::StaticOrder S; S.init(rows, GU_PHYS, G, bx);
                    EpiGU E{ACT, ssq_ffn};
                    pg8::gemm_phase<EpiGU, pg8::StaticOrder, PG8_ALIGN, PG8_SP2>(lds3, g, S, E);
                } else if (k == 5 && (PHMASK & 256)) {
                    pg8::Gemm g{ACT, (const bf16_t*)(wl + OW_D), rows, DM, DFF}; pg8::StaticOrder S; S.init(rows, DM, G, bx);
                    EpiRes E{XB, ssq_x};
                    pg8::gemm_phase<EpiRes, pg8::StaticOrder, PG8_ALIGN, PG8_SP2>(lds3, g, S, E);
                }
            }
        }
        if (ph + 1 < args.ph_hi && ph != 0) { if (ph == 1) { __threadfence(); cg::this_grid().sync(); } else {
 XcdBarrier xb_; xb_.bar = (unsigned*)(ws + WS_BAR); xb_.x = xb_xcc_id(); xb_.st = (volatile LAS unsigned*)(lds3 + 131072 + 1024); xcd_barrier(xb_); } }
    }
    }
}

extern "C" void kernel_launch(void* const* d_in, const int* in_sizes, int n_in, void* d_out, int out_size, void* d_ws, size_t ws_size, hipStream_t stream) {
    static int grid = 0;
    if (grid == 0) {
        if (n_in != 19 || out_size != MTOT * DM || ws_size < WS_END) { fprintf(stderr, "kernel_launch: unexpected shapes: n_in %d out %d ws %zu (need %zu)\n", n_in, out_size, ws_size, (size_t)WS_END); grid = -1; return; }
        int dev = 0, cus = 0, per_cu = 0;
        if (hipGetDevice(&dev) != hipSuccess || hipDeviceGetAttribute(&cus, hipDeviceAttributeMultiprocessorCount, dev) != hipSuccess) { grid = -1; return; }
        if (hipFuncSetAttribute((const void*)fwd_kernel, hipFuncAttributeMaxDynamicSharedMemorySize, LDS_BYTES) != hipSuccess) { fprintf(stderr, "kernel_launch: hipFuncSetAttribute failed\n"); grid = -1; return; }
        if (hipOccupancyMaxActiveBlocksPerMultiprocessor(&per_cu, (const void*)fwd_kernel, NTHR, LDS_BYTES) != hipSuccess || per_cu < 1) { fprintf(stderr, "kernel_launch: occupancy query says %d blocks per CU\n", per_cu); per_cu = 1; }
        (void)hipGetLastError();
        grid = cus;
    }
    if (grid < 0) return;
    if (hipMemsetAsync((char*)d_ws + WS_BAR, 0, BAR_BYTES, stream) != hipSuccess) { fprintf(stderr, "kernel_launch: memset failed\n"); return; }
    Args a{};
    for (int i = 0; i < 19; ++i) a.in[i] = (const float*)d_in[i];
    a.out = (float*)d_out; a.ws = (unsigned char*)d_ws;
#if defined(MK_MULTI)
    for (int ph = 0; ph < NPHASE; ++ph) { a.ph_lo = ph; a.ph_hi = ph + 1; hipLaunchKernelGGL(fwd_kernel, dim3(grid), dim3(NTHR), LDS_BYTES, stream, a); }
#else
    a.ph_lo = 0; a.ph_hi = NPHASE;
    void* kargs[] = {&a};
    hipError_t e = hipLaunchCooperativeKernel((const void*)fwd_kernel, dim3(grid), dim3(NTHR), kargs, LDS_BYTES, stream);
    if (e != hipSuccess) fprintf(stderr, "kernel_launch: cooperative launch failed: %s (grid %d)\n", hipGetErrorString(e), grid);
#endif
}
```

```cpp
#include <hip/hip_runtime.h>
#include <hip/hip_cooperative_groups.h>
#include <cstdio>
#include <cstdint>
namespace cg = cooperative_groups;
#ifndef PG8_SP2
#define PG8_SP2 true
#endif
#ifndef PG8_ALIGN
#define PG8_ALIGN true
#endif
__device__ __forceinline__ int ltid() { int t = threadIdx.x; asm volatile("" : "+v"(t)); return t; }
namespace pg8 {
#define PG8_LAS __attribute__((address_space(3)))
typedef unsigned short bf16_t;
typedef short bf16x8 __attribute__((ext_vector_type(8)));
typedef float f32x4 __attribute__((ext_vector_type(4)));
typedef unsigned u32x4 __attribute__((ext_vector_type(4)));
constexpr int BM = 256, BK = 64, HALF = 128, HTB = HALF * BK * 2  , STAGE_BYTES = 8 * HTB, NXCD = 8, WGM = 8;

__host__ __device__ __forceinline__ int lds_byte(int r, int c) { const int st = (r >> 4) * 2 + (c >> 5), rr = r & 15, cc = c & 31, ob = rr * 64 + cc * 2; return st * 1024 + (ob ^ (((ob >> 9) & 1) << 5)); }
__host__ __device__ __forceinline__ void stage_rc(int b, int& R, int& C) { const int st = b / 1024, sb = b % 1024, swz = sb ^ (((sb >> 9) & 1) << 5); R = (st >> 1) * 16 + swz / 64; C = (st & 1) * 32 + (swz % 64) / 2; }
__host__ __device__ __forceinline__ int perm32(int rho) { const int n = rho >> 4, i = rho & 15; return 8 * (i >> 2) + 4 * n + (i & 3); }

struct Unit { int pm, pn; };
struct Gemm { const bf16_t* A; const bf16_t* Bt; int M, N, K; };

struct StaticOrder {
    int nM, nN, nwg, G, c;
    __host__ __device__ void init(int M, int N, int G_, int c_) { nM = M / BM; nN = N / BM; nwg = nM * nN; G = G_; c = c_; }
    __host__ __device__ bool next(int i, Unit& u) const {
        const long L = (long)i * G + c; if (L >= nwg) return false;
        int wgid = (int)L; { const int q = nwg / NXCD, r = nwg % NXCD, xcd = wgid % NXCD, off = wgid / NXCD; wgid = (xcd < r ? xcd * (q + 1) : r * (q + 1) + (xcd - r) * q) + off; }
        const int nig = WGM * nN, gid = wgid / nig, fm = gid * WGM, gsz = (nM - fm) < WGM ? (nM - fm) : WGM;
        u.pm = fm + ((wgid % nig) % gsz); u.pn = (wgid % nig) / gsz; return true;
    }
    __device__ __forceinline__ void a_ready(const Unit&) const {}
    __device__ __forceinline__ void done(const Unit&) const {}
};
__device__ __forceinline__ unsigned cvt_pk_bf16(float lo, float hi) { unsigned r; asm volatile("v_cvt_pk_bf16_f32 %0, %1, %2" : "=v"(r) : "v"(lo), "v"(hi)); return r; }
template <class Epi, class Sched, bool ALIGN_EPI = false, bool SP2 = false>
__device__ __forceinline__ void gemm_phase(PG8_LAS unsigned char* lds, const Gemm g, const Sched& S, const Epi& E) {
    const int tid = ltid(), wid = __builtin_amdgcn_readfirstlane(tid >> 6), lane = tid & 63, wr = wid >> 2, wc = wid & 3, fr = lane & 15, fq = lane >> 4;
    const int K = g.K, nt = K / BK;
    unsigned voffA[2], voffB[2];
#pragma unroll
    for (int i = 0; i < 2; ++i) { int R, C; stage_rc(tid * 16 + i * 8192, R, C); const int Rb = Epi::PERM ? ((R & ~31) + perm32(R & 31)) : R;
        voffA[i] = (unsigned)(R * K + C) * 2u; voffB[i] = (unsigned)(Rb * K + C) * 2u; }
    const size_t kstep = (size_t)(BK * 2);
    const size_t hstep = (size_t)HALF * K * 2;
    const size_t tstep = 2 * hstep;
    const unsigned ldsw = (unsigned)wid * 1024u;
    const int aoff = lds_byte(wr * 64 + fr, fq * 8), boff = lds_byte(wc * 32 + fr, fq * 8);
#define PG8_SA(b, h) (((b) * 2 + (h)) * HTB)
#define PG8_SB(b, h) ((4 + (b) * 2 + (h)) * HTB)
#define PG8_STAGE(bufoff, gbase, voff) do { _Pragma("unroll") for (int _i = 0; _i < 2; ++_i) \
        __builtin_amdgcn_global_load_lds((const unsigned*)((const char*)(gbase) + (voff)[_i]), (PG8_LAS unsigned*)(lds + (bufoff) + ldsw + _i * 8192), 16, 0, 0); } while (0)
#define PG8_LDA(dst, b, h) do { _Pragma("unroll") for (int m = 0; m < 4; ++m) _Pragma("unroll") for (int k = 0; k < 2; ++k) dst[m][k] = *(const PG8_LAS bf16x8*)(lds + PG8_SA(b, h) + aoff + m * 2048 + k * 1024); } while (0)
#define PG8_LDB(dst, b, h) do { _Pragma("unroll") for (int n = 0; n < 2; ++n) _Pragma("unroll") for (int k = 0; k < 2; ++k) dst[n][k] = *(const PG8_LAS bf16x8*)(lds + PG8_SB(b, h) + boff + n * 2048 + k * 1024); } while (0)
#define PG8_MMA(ai, bj, At, Bt) do { __builtin_amdgcn_s_setprio(1); _Pragma("unroll") for (int m = 0; m < 4; ++m) _Pragma("unroll") for (int n = 0; n < 2; ++n) _Pragma("unroll") for (int k = 0; k < 2; ++k) \
        acc[ai][bj][m][n] = __builtin_amdgcn_mfma_f32_16x16x32_bf16(Bt[n][k], At[m][k], acc[ai][bj][m][n], 0, 0, 0); __builtin_amdgcn_s_setprio(0); } while (0)
#define PG8_WAIT_V(n) asm volatile("s_waitcnt vmcnt(" #n ")" ::: "memory")
#define PG8_WAIT_L(n) asm volatile("s_waitcnt lgkmcnt(" #n ")" ::: "memory")
#define PG8_BAR __builtin_amdgcn_s_barrier()
#define PG8_SCHED __builtin_amdgcn_sched_barrier(0)
    Unit cur, nxt; int ui = 0;
    if (!S.next(0, cur)) return;
    f32x4 acc[2][2][4][2];
#pragma unroll
    for (int a = 0; a < 2; ++a)
#pragma unroll
        for (int b = 0; b < 2; ++b)
#pragma unroll
            for (int m = 0; m < 4; ++m)
#pragma unroll
                for (int n = 0; n < 2; ++n) acc[a][b][m][n] = (f32x4){0.f, 0.f, 0.f, 0.f};
    bf16x8 At[4][2], B0[2][2], B1[2][2];
    const char* cA = (const char*)g.A + (size_t)cur.pm * tstep; const char* cB = (const char*)g.Bt + (size_t)cur.pn * tstep;
    S.a_ready(cur);
    if constexpr (SP2) {
        PG8_STAGE(PG8_SB(0, 0), cB, voffB); PG8_STAGE(PG8_SB(0, 1), cB + hstep, voffB); PG8_STAGE(PG8_SA(0, 0), cA, voffA); PG8_STAGE(PG8_SA(0, 1), cA + hstep, voffA);
        if (wr == 1) PG8_BAR;
        PG8_WAIT_V(2); PG8_BAR;
        PG8_STAGE(PG8_SB(1, 0), cB + kstep, voffB); PG8_STAGE(PG8_SA(1, 0), cA + kstep, voffA); PG8_STAGE(PG8_SB(1, 1), cB + hstep + kstep, voffB);
        PG8_WAIT_V(6); PG8_BAR;
    } else {
        PG8_STAGE(PG8_SB(0, 0), cB, voffB); PG8_STAGE(PG8_SA(0, 0), cA, voffA); PG8_STAGE(PG8_SB(0, 1), cB + hstep, voffB); PG8_STAGE(PG8_SA(0, 1), cA + hstep, voffA);
        if (wr == 1) PG8_BAR;
        PG8_WAIT_V(4); PG8_BAR;
        PG8_STAGE(PG8_SB(1, 0), cB + kstep, voffB); PG8_STAGE(PG8_SA(1, 0), cA + kstep, voffA); PG8_STAGE(PG8_SB(1, 1), cB + hstep + kstep, voffB);
        PG8_WAIT_V(6); PG8_BAR;
    }
    for (;;) {
        const bool has_next = S.next(ui + 1, nxt);
        const char* nA = has_next ? (const char*)g.A + (size_t)nxt.pm * tstep : cA; const char* nB = has_next ? (const char*)g.Bt + (size_t)nxt.pn * tstep : cB;
        for (int t = 0; t < nt; t += 2) {
            const bool last = (t == nt - 2);
            const char* a1 = cA + (size_t)(t + 1) * kstep;
            const char* a2 = last ? nA : cA + (size_t)(t + 2) * kstep; const char* b2 = last ? nB : cB + (size_t)(t + 2) * kstep;
            const char* a3 = a2 + kstep; const char* b3 = b2 + kstep;
            if (last && has_next) S.a_ready(nxt);
            if constexpr (SP2) {
            PG8_LDB(B0, 0, 0); PG8_LDB(B1, 0, 1); PG8_SCHED; PG8_LDA(At, 0, 0); PG8_STAGE(PG8_SA(1, 1), a1 + hstep, voffA);
            PG8_WAIT_V(8); PG8_WAIT_L(0); PG8_BAR; PG8_MMA(0, 0, At, B0); PG8_MMA(0, 1, At, B1); PG8_BAR; PG8_SCHED;
            PG8_LDA(At, 0, 1); PG8_STAGE(PG8_SB(0, 0), b2, voffB); PG8_STAGE(PG8_SB(0, 1), b2 + hstep, voffB); PG8_STAGE(PG8_SA(0, 0), a2, voffA);
            PG8_WAIT_V(8); PG8_WAIT_L(0); PG8_BAR; PG8_MMA(1, 0, At, B0); PG8_MMA(1, 1, At, B1); PG8_BAR; PG8_SCHED;
            PG8_LDB(B0, 1, 0); PG8_LDB(B1, 1, 1); PG8_SCHED; PG8_LDA(At, 1, 0); PG8_STAGE(PG8_SA(0, 1), a2 + hstep, voffA);
            PG8_WAIT_V(8); PG8_WAIT_L(0); PG8_BAR; PG8_MMA(0, 0, At, B0); PG8_MMA(0, 1, At, B1); PG8_BAR; PG8_SCHED;
            PG8_LDA(At, 1, 1); PG8_STAGE(PG8_SB(1, 0), b3, voffB); PG8_STAGE(PG8_SB(1, 1), b3 + hstep, voffB); PG8_STAGE(PG8_SA(1, 0), a3, voffA);
            PG8_WAIT_V(8); PG8_WAIT_L(0); PG8_BAR; PG8_MMA(1, 0, At, B0); PG8_MMA(1, 1, At, B1); PG8_BAR; PG8_SCHED;
            } else {
            PG8_LDB(B0, 0, 0); PG8_SCHED; PG8_LDA(At, 0, 0); PG8_STAGE(PG8_SA(1, 1), a1 + hstep, voffA);
            PG8_WAIT_L(8); PG8_BAR; PG8_WAIT_L(0); PG8_MMA(0, 0, At, B0); PG8_BAR; PG8_SCHED;
            PG8_LDB(B1, 0, 1); PG8_STAGE(PG8_SB(0, 0), b2, voffB);
            PG8_BAR; PG8_WAIT_L(0); PG8_MMA(0, 1, At, B1); PG8_BAR;
            PG8_LDA(At, 0, 1); PG8_STAGE(PG8_SA(0, 0), a2, voffA);
            PG8_BAR; PG8_WAIT_L(0); PG8_MMA(1, 0, At, B0); PG8_BAR; PG8_SCHED;
            PG8_STAGE(PG8_SB(0, 1), b2 + hstep, voffB);
            PG8_WAIT_V(6); PG8_BAR; PG8_MMA(1, 1, At, B1); PG8_BAR;
            PG8_LDB(B0, 1, 0); PG8_SCHED; PG8_LDA(At, 1, 0); PG8_STAGE(PG8_SA(0, 1), a2 + hstep, voffA);
            PG8_WAIT_L(8); PG8_BAR; PG8_WAIT_L(0); PG8_MMA(0, 0, At, B0); PG8_BAR; PG8_SCHED;
            PG8_LDB(B1, 1, 1); PG8_STAGE(PG8_SB(1, 0), b3, voffB);
            PG8_BAR; PG8_WAIT_L(0); PG8_MMA(0, 1, At, B1); PG8_BAR;
            PG8_LDA(At, 1, 1); PG8_STAGE(PG8_SA(1, 0), a3, voffA);
            PG8_BAR; PG8_WAIT_L(0); PG8_MMA(1, 0, At, B0); PG8_BAR; PG8_SCHED;
            PG8_STAGE(PG8_SB(1, 1), b3 + hstep, voffB);
            PG8_WAIT_V(6); PG8_BAR; PG8_MMA(1, 1, At, B1); PG8_BAR;
            }
        }
        if constexpr (ALIGN_EPI) { if (wr == 0) PG8_BAR; }
        if constexpr (!Epi::AFTER_DRAIN) { E(acc, cur, wr, wc, fr, fq); S.done(cur); }
        if (!has_next) break;
#pragma unroll
        for (int a = 0; a < 2; ++a)
#pragma unroll
            for (int b = 0; b < 2; ++b)
#pragma unroll
                for (int m = 0; m < 4; ++m)
#pragma unroll
                    for (int n = 0; n < 2; ++n) acc[a][b][m][n] = (f32x4){0.f, 0.f, 0.f, 0.f};
        cur = nxt; cA = nA; cB = nB; ++ui;
        if constexpr (ALIGN_EPI) { if (wr == 1) PG8_BAR; }
    }
    PG8_WAIT_V(0);
    if constexpr (!ALIGN_EPI) { if (wr == 0) PG8_BAR; }
    PG8_BAR;
    if constexpr (Epi::AFTER_DRAIN) { E.fused(acc, cur, wr, wc, fr, fq, lds, wid, lane); S.done(cur); }
#undef PG8_SA
#undef PG8_SB
#undef PG8_STAGE
#undef PG8_LDA
#undef PG8_LDB
#undef PG8_MMA
#undef PG8_WAIT_V
#undef PG8_WAIT_L
#undef PG8_BAR
#undef PG8_SCHED
}
}

constexpr int DM = 1024, SEQ = 2048, DEPTH = 2, DFF = 2816;
constexpr int ROWS0 = 16 * 2048, ROWS1 = 32 * 2048, MTOT = ROWS0 + ROWS1, RMAX = MTOT, NCH = 1;
constexpr int IN_COLS = 1984, IN_PHYS = 2048, GU_PHYS = 2 * DFF;
constexpr float EPS = 1e-6f;
constexpr float LOG2E = 1.4426950408889634f;
constexpr float QSCALE_D = 0.125f * LOG2E;
constexpr float QSCALE_M = 0.07216878364870322f * LOG2E;
constexpr int NWAVES = 8, NTHR = 512;
#ifndef REPK
#define REPK -2
#endif
#ifndef PHMASK
#define PHMASK 0xFFFF
#endif

using pg8::bf16_t; using pg8::bf16x8; using pg8::f32x4; using pg8::u32x4; using pg8::Unit; using pg8::cvt_pk_bf16;

constexpr size_t MiB = 1u << 20;
constexpr size_t WS_W = 0, W_LAYER = 25 * MiB;
constexpr size_t OW_IN = 0, OW_Q = 4 * MiB, OW_O = 6 * MiB, OW_GU = 8 * MiB, OW_D = 19 * MiB;
static_assert(OW_Q + 1792 * 384 * 2 <= OW_O && OW_D + (size_t)DM * DFF * 2 <= W_LAYER, "weight map");
constexpr size_t WS_ROPE = 50 * MiB, WS_SSQ = 842 * MiB, WS_BAR = 55 * MiB, BAR_BYTES = 16384, WS_STASH = 56 * MiB;
constexpr size_t WS_XB = 88 * MiB;
constexpr size_t WS_VD = 280 * MiB, WS_CQ = 376 * MiB, WS_QM = 448 * MiB, WS_KM = 592 * MiB, WS_VM = 736 * MiB, WS_END = 850 * MiB;
constexpr size_t WS_ACT = 280 * MiB;
constexpr size_t DO_AO = 0, DO_QD = 192 * MiB, DO_KD = 288 * MiB;
static_assert(WS_ACT + (size_t)RMAX * DFF * 2 <= 832 * MiB && WS_SSQ + (size_t)9 * MTOT * 8 <= WS_END && WS_XB + (size_t)MTOT * DM * 2 <= WS_VD, "workspace map");
constexpr int LDS_BYTES = 135168;

#define GAS __attribute__((address_space(1)))
__device__ __forceinline__ void st8(bf16_t* p, f32x4 a, f32x4 b) {
    u32x4 w; w.x = cvt_pk_bf16(a[0], a[1]); w.y = cvt_pk_bf16(a[2], a[3]); w.z = cvt_pk_bf16(b[0], b[1]); w.w = cvt_pk_bf16(b[2], b[3]);
    *(GAS u32x4*)p = w;
}
__device__ __forceinline__ f32x4 ld4g(const float* p) { return *(const GAS f32x4*)p; }
__device__ __forceinline__ float ld1g(const float* p) { return *(const GAS float*)p; }
__device__ __forceinline__ void st4g(float* p, f32x4 v) { *(GAS f32x4*)p = v; }
typedef unsigned long long u64;
constexpr float SSQ_FX = 16777216.0f, SSQ_IFX = 1.0f / 16777216.0f;
__device__ __forceinline__ void atomg(u64* p, float v) { (void)__hip_atomic_fetch_add((GAS u64*)p, (u64)(v * SSQ_FX), __ATOMIC_RELAXED, __HIP_MEMORY_SCOPE_AGENT); }
__device__ __forceinline__ float ldssq(const u64* p) { return (float)(*(const GAS u64*)p) * SSQ_IFX; }
__device__ __forceinline__ float sq8(f32x4 a, f32x4 b) { return (a[0] * a[0] + a[1] * a[1]) + (a[2] * a[2] + a[3] * a[3]) + (b[0] * b[0] + b[1] * b[1]) + (b[2] * b[2] + b[3] * b[3]); }
__device__ __forceinline__ float red_fq(float s) { s += __shfl_xor(s, 16); s += __shfl_xor(s, 32); return s; }
__device__ __forceinline__ void rope8r(f32x4 c0, f32x4 c1, f32x4 s0, f32x4 s1, f32x4& a0, f32x4& a1, f32x4& b0, f32x4& b1) {
    const f32x4 x0 = a0 * c0 - b0 * s0, x1 = a1 * c1 - b1 * s1, y0 = b0 * c0 + a0 * s0, y1 = b1 * c1 + a1 * s1;
    a0 = x0; a1 = x1; b0 = y0; b1 = y1;
}

struct EpiIn {
    static constexpr bool PERM = true, AFTER_DRAIN = false;
    bf16_t *Qd, *Kd, *Vd, *CQ, *CKV, *Km; const u64* ssq_in; u64* ssq_q; u64* ssq_kv; const float* rope;
    __device__ __forceinline__ void operator()(const f32x4 (&acc)[2][2][4][2], const Unit& u, int wr, int wc, int fr, int fq) const {
        { const int ln_ = ltid() & 63; fr = ln_ & 15; fq = ln_ >> 4; }
        const int pn = u.pn;
        const bool roped = (pn < 4) || (pn == 7 && wc == 3);
        const int row0 = u.pm * 256 + wr * 64 + fr;
        float rs[4][2]; f32x4 tb[4][2][4];
        f32x4 v[4][2][4];
#define EPI_ROW(b, mm) (row0 + ((b) >> 1) * 128 + (2 * ((b) & 1) + (mm)) * 16)
#define EPI_IN_LOAD(b) do { _Pragma("unroll") for (int mm = 0; mm < 2; ++mm) { const int row = EPI_ROW(b, mm); rs[b][mm] = ldssq(ssq_in + row); \
            if (roped) { const float* tab = rope + (row & (SEQ - 1)) * 64 + 8 * fq; tb[b][mm][0] = ld4g(tab); tb[b][mm][1] = ld4g(tab + 4); tb[b][mm][2] = ld4g(tab + 32); tb[b][mm][3] = ld4g(tab + 36); } } } while (0)
#define EPI_IN_COMP(b) do { _Pragma("unroll") for (int mm = 0; mm < 2; ++mm) { const float r = __builtin_amdgcn_rsqf(rs[b][mm] * (1.0f / 1024.0f) + EPS) * ((pn < 2) ? QSCALE_D : 1.0f); \
            const int ai = (b) >> 1, m = 2 * ((b) & 1) + mm; \
            v[b][mm][0] = acc[ai][0][m][0] * r; v[b][mm][1] = acc[ai][0][m][1] * r; v[b][mm][2] = acc[ai][1][m][0] * r; v[b][mm][3] = acc[ai][1][m][1] * r; \
            if (roped) rope8r(tb[b][mm][0], tb[b][mm][1], tb[b][mm][2], tb[b][mm][3], v[b][mm][0], v[b][mm][1], v[b][mm][2], v[b][mm][3]); } } while (0)
#define EPI_IN_STORE(b) do { _Pragma("unroll") for (int mm = 0; mm < 2; ++mm) { const int row = EPI_ROW(b, mm); \
            const f32x4 a0 = v[b][mm][0], a1 = v[b][mm][1], b0 = v[b][mm][2], b1 = v[b][mm][3]; \
            if (pn < 4) { bf16_t* dst = (pn < 2 ? Qd : Kd) + (size_t)row * 512 + (pn & 1) * 256 + wc * 64 + 8 * fq; st8(dst, a0, a1); st8(dst + 32, b0, b1); } \
            else if (pn < 6) { bf16_t* dst = Vd + (size_t)row * 512 + (pn - 4) * 256 + wc * 32 + 8 * fq; st8(dst, a0, a1); st8(dst + 128, b0, b1); } \
            else if (pn == 6) { bf16_t* dst = CQ + (size_t)row * 256 + wc * 32 + 8 * fq; st8(dst, a0, a1); st8(dst + 128, b0, b1); \
                const float s = red_fq(sq8(a0, a1) + sq8(b0, b1)); if (fq == 0) atomg(ssq_q + row, s); } \
            else if (wc < 3) { st8(Km + (size_t)row * 192 + wc * 32 + 8 * fq, a0, a1); float s = sq8(a0, a1); \
                if (wc == 0) { st8(Km + (size_t)row * 192 + 96 + 8 * fq, b0, b1); s += sq8(b0, b1); } \
                s = red_fq(s); if (fq == 0) atomg(ssq_kv + row, s); } \
            else { bf16_t* dst = Km + (size_t)row * 192 + 128 + 8 * fq; st8(dst, a0, a1); st8(dst + 32, b0, b1); } } } while (0)
        EPI_IN_LOAD(0); EPI_IN_COMP(0); EPI_IN_LOAD(1); EPI_IN_STORE(0); EPI_IN_COMP(1); EPI_IN_LOAD(2); EPI_IN_STORE(1); EPI_IN_COMP(2); EPI_IN_LOAD(3); EPI_IN_STORE(2); EPI_IN_COMP(3); EPI_IN_STORE(3);
#undef EPI_IN_LOAD
#undef EPI_IN_COMP
#undef EPI_IN_STORE
    }
};

struct EpiQKV {
    static constexpr bool PERM = true, AFTER_DRAIN = false;
    bf16_t *Qm, *Km, *Vm; const u64 *ssq_q, *ssq_kv; const float* rope;
    __device__ __forceinline__ void operator()(const f32x4 (&acc)[2][2][4][2], const Unit& u, int wr, int wc, int fr, int fq) const {
        const int pn = u.pn;
        const u64* ssq = pn < 3 ? ssq_q : ssq_kv; const float invk = pn < 3 ? (1.0f / 256.0f) : (1.0f / 128.0f), sc = pn < 3 ? QSCALE_M : 1.0f;
        char* d0; char* d1; unsigned ld0, ld1;
        if (pn < 2) { d0 = (char*)(Qm + (2 * pn) * 192 + wc * 32); d1 = d0 + 192 * 2; ld0 = ld1 = 768 * 2; }
        else if (pn == 2) { d0 = (char*)(Qm + wc * 192 + 128); d1 = d0 + 32 * 2; ld0 = ld1 = 768 * 2; }
        else { d0 = (char*)(Km + (pn - 3) * 192 + wc * 32); d1 = (char*)(Vm + (pn - 3) * 128 + wc * 32); ld0 = 768 * 2; ld1 = 512 * 2; }
        { const int ln_ = ltid() & 63; fr = ln_ & 15; fq = ln_ >> 4; }
        const unsigned row0 = u.pm * 256 + wr * 64 + fr, lo = 16 * fq;
#pragma unroll
        for (int ai = 0; ai < 2; ++ai)
#pragma unroll
            for (int m = 0; m < 4; ++m) {
                const unsigned row = row0 + ai * 128 + m * 16;
                const float r = __builtin_amdgcn_rsqf(ldssq(ssq + row) * invk + EPS) * sc;
                f32x4 a0 = acc[ai][0][m][0] * r, a1 = acc[ai][0][m][1] * r, b0 = acc[ai][1][m][0] * r, b1 = acc[ai][1][m][1] * r;
                if (pn == 2) { const float* tab = rope + (row & (SEQ - 1)) * 64 + 8 * fq; rope8r(ld4g(tab), ld4g(tab + 4), ld4g(tab + 32), ld4g(tab + 36), a0, a1, b0, b1); }
                st8((bf16_t*)(d0 + (row * ld0 + lo)), a0, a1); st8((bf16_t*)(d1 + (row * ld1 + lo)), b0, b1);
            }
#define EPI_Q_LOAD(b)
#define EPI_Q_COMP(b)
#define EPI_Q_STORE(b)
#undef EPI_Q_LOAD
#undef EPI_Q_COMP
#undef EPI_Q_STORE
    }
};

struct EpiRes {
    static constexpr bool PERM = true, AFTER_DRAIN = false;
    bf16_t* X; u64* ssq_out;
    __device__ __forceinline__ void operator()(const f32x4 (&acc)[2][2][4][2], const Unit& u, int wr, int wc, int fr, int fq) const {
        { const int ln_ = ltid() & 63; fr = ln_ & 15; fq = ln_ >> 4; }
        const size_t off0 = (size_t)(u.pm * 256 + wr * 64 + fr) * 1024 + u.pn * 256 + wc * 32 + 8 * fq;
        const int row0 = u.pm * 256 + wr * 64 + fr;
        u32x4 xin[2][4][2];
        f32x4 v[2][4][2][2];
#define EPI_R_LOAD(ai) do { _Pragma("unroll") for (int m = 0; m < 4; ++m) _Pragma("unroll") for (int bj = 0; bj < 2; ++bj) \
            xin[ai][m][bj] = *(const GAS u32x4*)(X + off0 + (size_t)((ai) * 128 + m * 16) * 1024 + bj * 128); } while (0)
#define EPI_R_COMP(ai) do { _Pragma("unroll") for (int m = 0; m < 4; ++m) _Pragma("unroll") for (int bj = 0; bj < 2; ++bj) { const u32x4 w = xin[ai][m][bj]; \
            const f32x4 x0 = {__uint_as_float(w.x << 16), __uint_as_float(w.x & 0xffff0000u), __uint_as_float(w.y << 16), __uint_as_float(w.y & 0xffff0000u)}; \
            const f32x4 x1 = {__uint_as_float(w.z << 16), __uint_as_float(w.z & 0xffff0000u), __uint_as_float(w.w << 16), __uint_as_float(w.w & 0xffff0000u)}; \
            v[ai][m][bj][0] = x0 + acc[ai][bj][m][0]; v[ai][m][bj][1] = x1 + acc[ai][bj][m][1]; } } while (0)
#define EPI_R_STORE(ai) do { _Pragma("unroll") for (int m = 0; m < 4; ++m) { float s = 0.f; const int rr = (ai) * 128 + m * 16; \
            _Pragma("unroll") for (int bj = 0; bj < 2; ++bj) { st8(X + off0 + (size_t)rr * 1024 + bj * 128, v[ai][m][bj][0], v[ai][m][bj][1]); s += sq8(v[ai][m][bj][0], v[ai][m][bj][1]); } \
            s = red_fq(s); if (fq == 0) atomg(ssq_out + row0 + rr, s); } } while (0)
        EPI_R_LOAD(0); EPI_R_LOAD(1); EPI_R_COMP(0); EPI_R_STORE(0); EPI_R_COMP(1); EPI_R_STORE(1);
#undef EPI_R_LOAD
#undef EPI_R_COMP
#undef EPI_R_STORE
    }
};

struct EpiGU {
    static constexpr bool PERM = true, AFTER_DRAIN = false;
    bf16_t* ACT; const u64* ssq_ffn;
    __device__ __forceinline__ void operator()(const f32x4 (&acc)[2][2][4][2], const Unit& u, int wr, int wc, int fr, int fq) const {
        { const int ln_ = ltid() & 63; fr = ln_ & 15; fq = ln_ >> 4; }
        const int row0 = u.pm * 256 + wr * 64 + fr;
        float rs[2][4];
#pragma unroll
        for (int ai = 0; ai < 2; ++ai)
#pragma unroll
            for (int m = 0; m < 4; ++m) rs[ai][m] = ldssq(ssq_ffn + row0 + ai * 128 + m * 16);
#pragma unroll
        for (int ai = 0; ai < 2; ++ai)
#pragma unroll
            for (int m = 0; m < 4; ++m) {
                const int row = row0 + ai * 128 + m * 16;
                const float r = __builtin_amdgcn_rsqf(rs[ai][m] * (1.0f / 1024.0f) + EPS);
                f32x4 o[2];
#pragma unroll
                for (int n = 0; n < 2; ++n) {
                    const f32x4 g = acc[ai][0][m][n] * r, up = acc[ai][1][m][n] * r;
#pragma unroll
                    for (int j = 0; j < 4; ++j) { const float e = __builtin_amdgcn_exp2f(-g[j] * LOG2E); o[n][j] = g[j] * up[j] * __builtin_amdgcn_rcpf(1.0f + e); }
                }
                st8(ACT + (size_t)row * DFF + u.pn * 128 + wc * 32 + 8 * fq, o[0], o[1]);
            }
    }
};

namespace att {
typedef short s16x4 __attribute__((ext_vector_type(4)));
typedef float f32x16 __attribute__((ext_vector_type(16)));
constexpr int KVBLK = 64, SHM_V = 16384, LDS_V = 0, LDS_K = 32768, SHM_KMAX = 24576, LDS_WS = LDS_K + 2 * SHM_KMAX;
constexpr float THR_L2 = 11.5f;
#define SBAR() __builtin_amdgcn_sched_barrier(0)
__device__ __forceinline__ int crow(int r, int hi) { return (r & 3) + 8 * (r >> 2) + 4 * hi; }
__device__ __forceinline__ unsigned cvtpk(float lo, float hi) { unsigned r; asm volatile("v_cvt_pk_bf16_f32 %0, %1, %2" : "=v"(r) : "v"(lo), "v"(hi)); return r; }

__device__ __forceinline__ void partialSM(f32x16& p0, f32x16& p1, float& m_reg, float& mn, float& alpha, bool first) {
    float pmax = p0[0];
#pragma unroll
    for (int r = 1; r < 16; ++r) pmax = fmaxf(pmax, p0[r]);
#pragma unroll
    for (int r = 0; r < 16; ++r) pmax = fmaxf(pmax, p1[r]);
    { auto rr = __builtin_amdgcn_permlane32_swap(__float_as_uint(pmax), __float_as_uint(pmax), false, false);
      pmax = fmaxf(__uint_as_float(rr[0]), __uint_as_float(rr[1])); }
    if (__builtin_expect(!first && __all(pmax <= THR_L2), 1)) { mn = m_reg; alpha = 1.f; }
    else { const float d = first ? pmax : fmaxf(pmax, 0.f); mn = m_reg + d; alpha = first ? 0.f : __builtin_amdgcn_exp2f(-d); m_reg = mn;
#pragma unroll
        for (int r = 0; r < 16; ++r) p0[r] = p0[r] - d;
#pragma unroll
        for (int r = 0; r < 16; ++r) p1[r] = p1[r] - d; }
#pragma unroll
    for (int r = 0; r < 16; ++r) p0[r] = __builtin_amdgcn_exp2f(p0[r]);
}
__device__ __forceinline__ void finishSM(f32x16& p0, f32x16& p1, float alpha, float& l_reg, bf16x8& pa0, bf16x8& pa1, bf16x8& pa2, bf16x8& pa3) {
#pragma unroll
    for (int r = 0; r < 16; ++r) p1[r] = __builtin_amdgcn_exp2f(p1[r]);
    float ps = 0;
#pragma unroll
    for (int r = 0; r < 16; ++r) ps += p0[r];
#pragma unroll
    for (int r = 0; r < 16; ++r) ps += p1[r];
    { auto rr = __builtin_amdgcn_permlane32_swap(__float_as_uint(ps), __float_as_uint(ps), false, false);
      ps = __uint_as_float(rr[0]) + __uint_as_float(rr[1]); }
    l_reg = l_reg * alpha + ps;
#define PK4(P, BASE, OUT) do { unsigned a0 = cvtpk(P[BASE + 0], P[BASE + 1]), a1 = cvtpk(P[BASE + 2], P[BASE + 3]);   \
    unsigned b0 = cvtpk(P[BASE + 4], P[BASE + 5]), b1 = cvtpk(P[BASE + 6], P[BASE + 7]);                              \
    auto r0 = __builtin_amdgcn_permlane32_swap(a0, b0, false, false); auto r1 = __builtin_amdgcn_permlane32_swap(a1, b1, false, false); \
    u32x4 w = {r0[0], r1[0], r0[1], r1[1]}; OUT = *reinterpret_cast<bf16x8*>(&w); } while (0)
    PK4(p0, 0, pa0); PK4(p0, 8, pa1); PK4(p1, 0, pa2); PK4(p1, 8, pa3);
#undef PK4
}
__device__ __forceinline__ void finishLite(f32x16& p0, f32x16& p1, bf16x8& pa0, bf16x8& pa1, bf16x8& pa2, bf16x8& pa3) {
#define PK4(P, BASE, OUT) do { unsigned a0 = cvtpk(P[BASE + 0], P[BASE + 1]), a1 = cvtpk(P[BASE + 2], P[BASE + 3]);   \
    unsigned b0 = cvtpk(P[BASE + 4], P[BASE + 5]), b1 = cvtpk(P[BASE + 6], P[BASE + 7]);                              \
    auto r0 = __builtin_amdgcn_permlane32_swap(a0, b0, false, false); auto r1 = __builtin_amdgcn_permlane32_swap(a1, b1, false, false); \
    u32x4 w = {r0[0], r1[0], r0[1], r1[1]}; OUT = *reinterpret_cast<bf16x8*>(&w); } while (0)
    PK4(p0, 0, pa0); PK4(p0, 8, pa1); PK4(p1, 0, pa2); PK4(p1, 8, pa3);
#undef PK4
}
template <int DQK>
__device__ __forceinline__ void qkt(f32x16& p0, f32x16& p1, const char* Ks, const bf16x8* qr, int r32, int hi, float negm) {
    constexpr int KROWB = DQK * 2;
#pragma unroll
    for (int r = 0; r < 16; ++r) { p0[r] = negm; p1[r] = negm; }
    const int sw = ((r32 >> 1) & 7) << 4;
#pragma unroll
    for (int d0 = 0; d0 < DQK / 16; ++d0) { const int cb = (d0 * 16 + hi * 8) * 2;
        bf16x8 b0 = *reinterpret_cast<const bf16x8*>(Ks + r32 * KROWB + (cb ^ sw));
        bf16x8 b1 = *reinterpret_cast<const bf16x8*>(Ks + (32 + r32) * KROWB + (cb ^ sw));
        p0 = __builtin_amdgcn_mfma_f32_32x32x16_bf16(b0, qr[d0], p0, 0, 0, 0);
        p1 = __builtin_amdgcn_mfma_f32_32x32x16_bf16(b1, qr[d0], p1, 0, 0, 0); }
}
__device__ __forceinline__ int v_st(int k, int c) { const int kk = (k & ~0xC) | ((k & 4) << 1) | ((k & 8) >> 1); return ((kk >> 3) * 4 + (c >> 5)) * 512 + ((kk & 7) * 32 + (c & 31)) * 2; }
__device__ __forceinline__ int v_rd_base(int lane) { return ((lane & 3) << 3) | (((lane >> 2) & 3) << 6) | (((lane >> 4) & 1) << 5) | (((lane >> 5) & 1) << 8); }
#define TK(j_) ((((j_) + rot) & (SEQ / KVBLK - 1)) * KVBLK)
constexpr int v_rd_off(int d0, int ks, int half) { return d0 * 512 + ks * 4096 + half * 2048; }
template <int OFF> __device__ __forceinline__ s16x4 tr_read(int vb) {
    s16x4 r; asm volatile("ds_read_b64_tr_b16 %0, %1 offset:%2" : "=&v"(r) : "v"(vb), "i"(OFF) : "memory"); return r;
}
struct VFrag { s16x4 l0, h0, l1, h1, l2, h2, l3, h3; };
template <int D0> __device__ __forceinline__ void v_reads(VFrag& f, int vb) {
    f.l0 = tr_read<v_rd_off(D0, 0, 0)>(vb); f.h0 = tr_read<v_rd_off(D0, 0, 1)>(vb); f.l1 = tr_read<v_rd_off(D0, 1, 0)>(vb); f.h1 = tr_read<v_rd_off(D0, 1, 1)>(vb);
    f.l2 = tr_read<v_rd_off(D0, 2, 0)>(vb); f.h2 = tr_read<v_rd_off(D0, 2, 1)>(vb); f.l3 = tr_read<v_rd_off(D0, 3, 0)>(vb); f.h3 = tr_read<v_rd_off(D0, 3, 1)>(vb);
}
__device__ __forceinline__ void pv_mma(f32x16& od, const VFrag& f, bf16x8 pa0, bf16x8 pa1, bf16x8 pa2, bf16x8 pa3) {
#define PK(L, H) (bf16x8){L[0], L[1], L[2], L[3], H[0], H[1], H[2], H[3]}
    od = __builtin_amdgcn_mfma_f32_32x32x16_bf16(pa0, PK(f.l0, f.h0), od, 0, 0, 0);
    od = __builtin_amdgcn_mfma_f32_32x32x16_bf16(pa1, PK(f.l1, f.h1), od, 0, 0, 0);
    od = __builtin_amdgcn_mfma_f32_32x32x16_bf16(pa2, PK(f.l2, f.h2), od, 0, 0, 0);
    od = __builtin_amdgcn_mfma_f32_32x32x16_bf16(pa3, PK(f.l3, f.h3), od, 0, 0, 0);
#undef PK
}
__device__ __forceinline__ void pv_d0(f32x16* o, int vb, bf16x8 pa0, bf16x8 pa1, bf16x8 pa2, bf16x8 pa3) {
    VFrag fa, fb;
    v_reads<0>(fa, vb); v_reads<1>(fb, vb);
    asm volatile("s_waitcnt lgkmcnt(8)" ::: "memory"); SBAR(); pv_mma(o[0], fa, pa0, pa1, pa2, pa3);
    v_reads<2>(fa, vb);
    asm volatile("s_waitcnt lgkmcnt(8)" ::: "memory"); SBAR(); pv_mma(o[1], fb, pa0, pa1, pa2, pa3);
    v_reads<3>(fb, vb);
    asm volatile("s_waitcnt lgkmcnt(8)" ::: "memory"); SBAR(); pv_mma(o[2], fa, pa0, pa1, pa2, pa3);
    asm volatile("s_waitcnt lgkmcnt(0)" ::: "memory"); SBAR(); pv_mma(o[3], fb, pa0, pa1, pa2, pa3);
}

template <int D0> __device__ __forceinline__ void pv_one_s(f32x16& od, int vb, bf16x8 pa0, bf16x8 pa1, bf16x8 pa2, bf16x8 pa3) {
    VFrag f; v_reads<D0>(f, vb);
    asm volatile("s_waitcnt lgkmcnt(0)" ::: "memory"); SBAR();
    pv_mma(od, f, pa0, pa1, pa2, pa3);
}
template <bool DB> __device__ __forceinline__ void pv_sel(f32x16* o, int vb, bf16x8 pa0, bf16x8 pa1, bf16x8 pa2, bf16x8 pa3) {
    if constexpr (DB) pv_d0(o, vb, pa0, pa1, pa2, pa3);
    else { pv_one_s<0>(o[0], vb, pa0, pa1, pa2, pa3); pv_one_s<1>(o[1], vb, pa0, pa1, pa2, pa3); pv_one_s<2>(o[2], vb, pa0, pa1, pa2, pa3); pv_one_s<3>(o[3], vb, pa0, pa1, pa2, pa3); }
}

template <int DQK, int ldq, int ldk, int ldv, int VAR>
__device__ __forceinline__ void attn_core(const bf16_t* __restrict__ Qb, const bf16_t* __restrict__ Kh,
                                          const bf16_t* __restrict__ Vh, char* lds, f32x16 (&o)[4], float (&rli)[16], int rot) {
    constexpr int ND = DQK / 16, KROWB = DQK * 2, SHM_K = 64 * KROWB, NKC = DQK / 64, CPR = DQK / 8;
    const int tid = ltid(), wid = tid >> 6, lane = tid & 63, r32 = lane & 31, hi = lane >> 5;
    char* V_lds = lds + LDS_V; char* K_lds = lds + LDS_K;
    float* ws = (float*)(lds + LDS_WS) + wid * 64; float* li_l = ws; float* al_l = ws + 32;
    float m_reg = 0.f, l_reg = 0;
#pragma unroll
    for (int d = 0; d < 4; ++d) o[d] = f32x16{};
    bf16x8 qr[ND];
    const bf16_t* Qw = Qb + (size_t)(wid * 32 + r32) * ldq + hi * 8;
#pragma unroll
    for (int d0 = 0; d0 < ND; ++d0) qr[d0] = *reinterpret_cast<const bf16x8*>(Qw + d0 * 16);
    const int sr = tid >> 4, sc = (tid & 15) * 8, vst0 = v_st(sr, sc), vst1 = v_st(32 + sr, sc);
    int kg_off[NKC], kl_off[NKC];
#pragma unroll
    for (int i = 0; i < NKC; ++i) { const int cid = tid + 512 * i, kr = cid / CPR, kc = cid % CPR; kg_off[i] = kr * ldk + kc * 8; kl_off[i] = kr * KROWB + ((kc * 16) ^ (((kr >> 1) & 7) << 4)); }
    const int vb0 = (int)(uintptr_t)V_lds + v_rd_base(lane);
    bf16x8 vs0, vs1, ks[NKC];
#define SLOAD(k0) do { if constexpr (VAR == 4) break; vs0 = *reinterpret_cast<const bf16x8*>(&Vh[(size_t)((k0) + sr) * ldv + sc]); vs1 = *reinterpret_cast<const bf16x8*>(&Vh[(size_t)((k0) + 32 + sr) * ldv + sc]); \
    _Pragma("unroll") for (int i_ = 0; i_ < NKC; ++i_) ks[i_] = *reinterpret_cast<const bf16x8*>(&Kh[(size_t)(k0) * ldk + kg_off[i_]]); } while (0)
#define SWRITE(b) do { if constexpr (VAR == 4) break; *(bf16x8*)(V_lds + (b) * SHM_V + vst0) = vs0; *(bf16x8*)(V_lds + (b) * SHM_V + vst1) = vs1; \
    _Pragma("unroll") for (int i_ = 0; i_ < NKC; ++i_) *(bf16x8*)(K_lds + (b) * SHM_K + kl_off[i_]) = ks[i_]; } while (0)
#define SWAIT() asm volatile("s_waitcnt vmcnt(0)" ::: "memory")
#define RESC(a) do { if (__any((a) < 1.f)) { if (hi == 0) al_l[r32] = (a); asm volatile("s_waitcnt lgkmcnt(0)" ::: "memory"); \
    _Pragma("unroll") for (int d = 0; d < 4; ++d) _Pragma("unroll") for (int r = 0; r < 16; ++r) o[d][r] *= al_l[crow(r, hi)]; } } while (0)
    f32x16 pA0, pA1, pB0, pB1; float mnA, mnB, alA, alB; bf16x8 pa0, pa1, pa2, pa3; constexpr int NT = SEQ / KVBLK;
    __syncthreads();
    SLOAD(TK(0)); SWAIT(); SWRITE(0); __syncthreads();
    do { if constexpr (VAR != 3) qkt<DQK>(pA0, pA1, K_lds, qr, r32, hi, -m_reg); else { pA0 = f32x16{}; pA1 = f32x16{}; } } while (0); do { if constexpr (VAR != 1) partialSM(pA0, pA1, m_reg, mnA, alA, true); else { mnA = m_reg; alA = 1.f; } } while (0);
    SLOAD(TK(1));
    SWAIT(); SWRITE(1); __syncthreads();
#pragma unroll 1
    for (int j = 1; j + 1 < NT; j += 2) {
        SBAR(); do { if constexpr (VAR != 3) qkt<DQK>(pB0, pB1, K_lds + SHM_K, qr, r32, hi, -m_reg); else { pB0 = f32x16{}; pB1 = f32x16{}; } } while (0);
        do { if constexpr (VAR != 1) finishSM(pA0, pA1, alA, l_reg, pa0, pa1, pa2, pa3); else finishLite(pA0, pA1, pa0, pa1, pa2, pa3); } while (0); SBAR();
        SLOAD(TK(j + 1)); SBAR();
        do { if constexpr (VAR != 2) pv_d0(o, vb0, pa0, pa1, pa2, pa3); } while (0); do { if constexpr (VAR != 1) partialSM(pB0, pB1, m_reg, mnB, alB, false); else { mnB = m_reg; alB = 1.f; } } while (0);
        __syncthreads(); SWAIT(); SWRITE(0);
        RESC(alB); __syncthreads();
        SBAR(); do { if constexpr (VAR != 3) qkt<DQK>(pA0, pA1, K_lds, qr, r32, hi, -m_reg); else { pA0 = f32x16{}; pA1 = f32x16{}; } } while (0);
        do { if constexpr (VAR != 1) finishSM(pB0, pB1, alB, l_reg, pa0, pa1, pa2, pa3); else finishLite(pB0, pB1, pa0, pa1, pa2, pa3); } while (0); SBAR();
        SLOAD(TK(j + 2)); SBAR();
        do { if constexpr (VAR != 2) pv_d0(o, vb0 + SHM_V, pa0, pa1, pa2, pa3); } while (0); do { if constexpr (VAR != 1) partialSM(pA0, pA1, m_reg, mnA, alA, false); else { mnA = m_reg; alA = 1.f; } } while (0);
        __syncthreads(); SWAIT(); SWRITE(1);
        RESC(alA); __syncthreads();
    }
    SBAR(); do { if constexpr (VAR != 3) qkt<DQK>(pB0, pB1, K_lds + SHM_K, qr, r32, hi, -m_reg); else { pB0 = f32x16{}; pB1 = f32x16{}; } } while (0);
    do { if constexpr (VAR != 1) finishSM(pA0, pA1, alA, l_reg, pa0, pa1, pa2, pa3); else finishLite(pA0, pA1, pa0, pa1, pa2, pa3); } while (0); SBAR();
    do { if constexpr (VAR != 2) pv_d0(o, vb0, pa0, pa1, pa2, pa3); } while (0); do { if constexpr (VAR != 1) partialSM(pB0, pB1, m_reg, mnB, alB, false); else { mnB = m_reg; alB = 1.f; } } while (0);
    __syncthreads(); RESC(alB);
    do { if constexpr (VAR != 1) finishSM(pB0, pB1, alB, l_reg, pa0, pa1, pa2, pa3); else finishLite(pB0, pB1, pa0, pa1, pa2, pa3); } while (0); SBAR();
    do { if constexpr (VAR != 2) pv_d0(o, vb0 + SHM_V, pa0, pa1, pa2, pa3); } while (0);
    if (hi == 0) li_l[r32] = l_reg; asm volatile("s_waitcnt lgkmcnt(0)" ::: "memory");
#pragma unroll
    for (int r = 0; r < 16; ++r) rli[r] = __builtin_amdgcn_rcpf(li_l[crow(r, hi)]);
#undef SLOAD
#undef SWRITE
#undef SWAIT
#undef RESC
}

template <int DQK, int ldq, int ldk, int ldv, int VAR, bool MQA>
__device__ __forceinline__ void attn_core1(const bf16_t* __restrict__ Qb, const bf16_t* __restrict__ Kh,
                                           const bf16_t* __restrict__ Vh, char* lds, f32x16 (&o)[4], float (&rli)[16], int rot) {
    constexpr int ND = DQK / 16, KROWB = DQK * 2, SHM_K = 64 * KROWB, NKC = DQK / 64, CPR = DQK / 8;
    const int tid = ltid(), wid = tid >> 6, lane = tid & 63, r32 = lane & 31, hi = lane >> 5;
    char* V_lds = lds + LDS_V; char* K_lds = lds + LDS_K;
    float* ws = (float*)(lds + LDS_WS) + wid * 64; float* li_l = ws; float* al_l = ws + 32;
    float m_reg = 0.f, l_reg = 0;
#pragma unroll
    for (int d = 0; d < 4; ++d) o[d] = f32x16{};
    bf16x8 qr[ND];
    const bf16_t* Qw = MQA ? Qb + (size_t)((wid & 1) * 32 + r32) * ldq + (wid >> 1) * DQK + hi * 8 : Qb + (size_t)(wid * 32 + r32) * ldq + hi * 8;
#pragma unroll
    for (int d0 = 0; d0 < ND; ++d0) qr[d0] = *reinterpret_cast<const bf16x8*>(Qw + d0 * 16);
    const int sr = tid >> 4, sc = (tid & 15) * 8, vst0 = v_st(sr, sc), vst1 = v_st(32 + sr, sc);
    int kg_off[NKC], kl_off[NKC];
#pragma unroll
    for (int i = 0; i < NKC; ++i) { const int cid = tid + 512 * i, kr = cid / CPR, kc = cid % CPR; kg_off[i] = kr * ldk + kc * 8; kl_off[i] = kr * KROWB + ((kc * 16) ^ (((kr >> 1) & 7) << 4)); }
    const int vb0 = (int)(uintptr_t)V_lds + v_rd_base(lane);
    bf16x8 vs0, vs1, ks[NKC];
#define SLOAD(k0) do { if constexpr (VAR == 4) break; vs0 = *reinterpret_cast<const bf16x8*>(&Vh[(size_t)((k0) + sr) * ldv + sc]); vs1 = *reinterpret_cast<const bf16x8*>(&Vh[(size_t)((k0) + 32 + sr) * ldv + sc]); \
    _Pragma("unroll") for (int i_ = 0; i_ < NKC; ++i_) ks[i_] = *reinterpret_cast<const bf16x8*>(&Kh[(size_t)(k0) * ldk + kg_off[i_]]); } while (0)
#define SWRITE(b) do { if constexpr (VAR == 4) break; *(bf16x8*)(V_lds + (b) * SHM_V + vst0) = vs0; *(bf16x8*)(V_lds + (b) * SHM_V + vst1) = vs1; \
    _Pragma("unroll") for (int i_ = 0; i_ < NKC; ++i_) *(bf16x8*)(K_lds + (b) * SHM_K + kl_off[i_]) = ks[i_]; } while (0)
#define SWAIT() asm volatile("s_waitcnt vmcnt(0)" ::: "memory")
#define RESC(a) do { if (__any((a) < 1.f)) { if (hi == 0) al_l[r32] = (a); asm volatile("s_waitcnt lgkmcnt(0)" ::: "memory"); \
    _Pragma("unroll") for (int d = 0; d < 4; ++d) _Pragma("unroll") for (int r = 0; r < 16; ++r) o[d][r] *= al_l[crow(r, hi)]; } } while (0)
    f32x16 p0, p1; float mn, al; bf16x8 pa0, pa1, pa2, pa3; constexpr int NT = SEQ / KVBLK;
    __syncthreads();
    SLOAD(TK(0)); SWAIT(); SWRITE(0); SLOAD(TK(1)); __syncthreads();
#pragma unroll 1
    for (int j = 0; j < NT; ++j) {
        const int cur = j & 1;
        SBAR(); do { if constexpr (VAR != 3) qkt<DQK>(p0, p1, K_lds + cur * SHM_K, qr, r32, hi, -m_reg); else { p0 = f32x16{}; p1 = f32x16{}; } } while (0);
        if (j + 1 < NT) { SWAIT(); SWRITE(cur ^ 1); }
        if (j + 2 < NT) SLOAD(TK(j + 2));
        SBAR();
        do { if constexpr (VAR != 1) partialSM(p0, p1, m_reg, mn, al, j == 0); else { mn = m_reg; al = 1.f; } } while (0); RESC(al);
        do { if constexpr (VAR != 1) finishSM(p0, p1, al, l_reg, pa0, pa1, pa2, pa3); else finishLite(p0, p1, pa0, pa1, pa2, pa3); } while (0); SBAR();
        do { if constexpr (VAR != 2) pv_d0(o, vb0 + cur * SHM_V, pa0, pa1, pa2, pa3); } while (0);
        __syncthreads();
    }
    if (hi == 0) li_l[r32] = l_reg; asm volatile("s_waitcnt lgkmcnt(0)" ::: "memory");
#pragma unroll
    for (int r = 0; r < 16; ++r) rli[r] = __builtin_amdgcn_rcpf(li_l[crow(r, hi)]);
#undef SLOAD
#undef SWRITE
#undef SWAIT
#undef RESC
}


template <int DQK, int ldq, int ldk, int ldv, int VAR, bool MQA>
__device__ __forceinline__ void attn_core1d(const bf16_t* __restrict__ Qb, const bf16_t* __restrict__ Kh,
                                            const bf16_t* __restrict__ Vh, char* lds, f32x16 (&o)[4], float (&rli)[16], int rot) {
    constexpr int ND = DQK / 16, KROWB = DQK * 2, SHM_K = 64 * KROWB, NKP = SHM_K / 8192;
    const int tid = ltid(), wid = tid >> 6, lane = tid & 63, r32 = lane & 31, hi = lane >> 5;
    const int widu = __builtin_amdgcn_readfirstlane(wid);
    char* V_lds = lds + LDS_V; char* K_lds = lds + LDS_K;
    float* ws = (float*)(lds + LDS_WS) + wid * 64; float* li_l = ws; float* al_l = ws + 32;
    float m_reg = 0.f, l_reg = 0;
#pragma unroll
    for (int d = 0; d < 4; ++d) o[d] = f32x16{};
    bf16x8 qr[ND];
    const bf16_t* Qw = MQA ? Qb + (size_t)((wid & 1) * 32 + r32) * ldq + (wid >> 1) * DQK + hi * 8 : Qb + (size_t)(wid * 32 + r32) * ldq + hi * 8;
#pragma unroll
    for (int d0 = 0; d0 < ND; ++d0) qr[d0] = *reinterpret_cast<const bf16x8*>(Qw + d0 * 16);
    int kgo[NKP], vgo[2];
#pragma unroll
    for (int i = 0; i < NKP; ++i) { const int b = (widu + 8 * i) * 1024 + 16 * lane, kr = b / KROWB, cs = (b % KROWB) >> 4, c = (cs & ~7) | ((cs & 7) ^ ((kr >> 1) & 7)); kgo[i] = kr * ldk + c * 8; }
#pragma unroll
    for (int i = 0; i < 2; ++i) { const int b = (widu + 8 * i) * 1024 + 16 * lane, st = b >> 9, w2 = (b & 511) >> 1, kk = (st >> 2) * 8 + (w2 >> 5), k = (kk & ~0xC) | ((kk & 4) << 1) | ((kk & 8) >> 1), c = (st & 3) * 32 + (w2 & 31); vgo[i] = k * ldv + c; }
    const int vb0 = (int)(uintptr_t)V_lds + v_rd_base(lane);
    PG8_LAS unsigned char* lds3 = (PG8_LAS unsigned char*)lds;
#define DMA(k0, buf) do { if constexpr (VAR == 4) break; \
    _Pragma("unroll") for (int i_ = 0; i_ < NKP; ++i_) __builtin_amdgcn_global_load_lds((const unsigned*)(Kh + (size_t)(k0) * ldk + kgo[i_]), (PG8_LAS unsigned*)(lds3 + LDS_K + (buf) * SHM_K + (widu + 8 * i_) * 1024), 16, 0, 0); \
    _Pragma("unroll") for (int i_ = 0; i_ < 2; ++i_) __builtin_amdgcn_global_load_lds((const unsigned*)(Vh + (size_t)(k0) * ldv + vgo[i_]), (PG8_LAS unsigned*)(lds3 + LDS_V + (buf) * SHM_V + (widu + 8 * i_) * 1024), 16, 0, 0); } while (0)
#define RESC(a) do { if (__any((a) < 1.f)) { if (hi == 0) al_l[r32] = (a); asm volatile("s_waitcnt lgkmcnt(0)" ::: "memory"); \
    _Pragma("unroll") for (int d = 0; d < 4; ++d) _Pragma("unroll") for (int r = 0; r < 16; ++r) o[d][r] *= al_l[crow(r, hi)]; } } while (0)
    f32x16 p0, p1; float mn, al; bf16x8 pa0, pa1, pa2, pa3; constexpr int NT = SEQ / KVBLK;
    __syncthreads();
    DMA(TK(0), 0); asm volatile("s_waitcnt vmcnt(0)" ::: "memory"); __syncthreads();
#pragma unroll 1
    for (int j = 0; j < NT; ++j) {
        const int cur = j & 1;
        if (j + 1 < NT) DMA(TK(j + 1), cur ^ 1);
        SBAR(); do { if constexpr (VAR != 3) qkt<DQK>(p0, p1, K_lds + cur * SHM_K, qr, r32, hi, -m_reg); else { p0 = f32x16{}; p1 = f32x16{}; } } while (0);
        do { if constexpr (VAR != 1) partialSM(p0, p1, m_reg, mn, al, j == 0); else { mn = m_reg; al = 1.f; } } while (0); RESC(al);
        do { if constexpr (VAR != 1) finishSM(p0, p1, al, l_reg, pa0, pa1, pa2, pa3); else finishLite(p0, p1, pa0, pa1, pa2, pa3); } while (0); SBAR();
        do { if constexpr (VAR != 2) pv_d0(o, vb0 + cur * SHM_V, pa0, pa1, pa2, pa3); } while (0);
        asm volatile("s_waitcnt vmcnt(0)" ::: "memory");
        __syncthreads();
    }
    if (hi == 0) li_l[r32] = l_reg; asm volatile("s_waitcnt lgkmcnt(0)" ::: "memory");
#pragma unroll
    for (int r = 0; r < 16; ++r) rli[r] = __builtin_amdgcn_rcpf(li_l[crow(r, hi)]);
#undef DMA
#undef RESC
}
__device__ __forceinline__ bf16_t f2bf(float x) { return (bf16_t)(cvtpk(x, x) & 0xffffu); }
}

struct AttnPtrs { const bf16_t *Qd, *Kd, *Vd, *Qm, *Km, *Vm; bf16_t* AO; float* stash; const float* subln; float lam_init; };

template <int VAR> __device__ __forceinline__ void mla_unit(const AttnPtrs& P, int seq, int qb64, char* lds) {
    const int tid = ltid(), wid = tid >> 6, lane = tid & 63, r32 = lane & 31, hi = lane >> 5;
    const size_t rowq = (size_t)seq * SEQ + qb64 * 64, rowk = (size_t)seq * SEQ;
    att::f32x16 o[4]; float rli[16];
    att::attn_core1d<192, 768, 192, 192, VAR, true>(P.Qm + rowq * 768, P.Km + rowk * 192, P.Km + rowk * 192, lds, o, rli, (qb64 & 7) * 4);
    bf16_t* Ow = P.AO + (rowq + (wid & 1) * 32 + 4 * hi) * 1024 + 512 + (wid >> 1) * 128 + r32;
#pragma unroll
    for (int r = 0; r < 16; ++r) { bf16_t* pr = Ow + ((r & 3) + 8 * (r >> 2)) * 1024; asm volatile("" : "+v"(pr));
#pragma unroll
        for (int d0 = 0; d0 < 4; ++d0) pr[d0 * 32] = att::f2bf(o[d0][r] * rli[r]); }
}

template <int VAR> __device__ __forceinline__ void diff_unit(const AttnPtrs& P, int seq, int h, int qb, float lam, char* lds) {
    const int tid = ltid(), wid = tid >> 6, lane = tid & 63, r32 = lane & 31, hi = lane >> 5;
    const size_t rowq = (size_t)seq * SEQ + qb * 256, rowk = (size_t)seq * SEQ;
    float* st = P.stash + (size_t)blockIdx.x * 32768 + tid * 64;
    att::f32x16 o[4]; float rli[16];
    att::attn_core1d<64, 512, 512, 512, VAR, false>(P.Qd + rowq * 512 + (2 * h) * 64, P.Kd + rowk * 512 + (2 * h) * 64, P.Vd + rowk * 512 + h * 128, lds, o, rli, qb * 4);
#pragma unroll
    for (int d0 = 0; d0 < 4; ++d0)
#pragma unroll
        for (int r = 0; r < 16; r += 4) *(f32x4*)(st + d0 * 16 + r) = (f32x4){o[d0][r] * rli[r], o[d0][r + 1] * rli[r + 1], o[d0][r + 2] * rli[r + 2], o[d0][r + 3] * rli[r + 3]};
    att::attn_core1d<64, 512, 512, 512, VAR, false>(P.Qd + rowq * 512 + (2 * h + 1) * 64, P.Kd + rowk * 512 + (2 * h + 1) * 64, P.Vd + rowk * 512 + h * 128, lds, o, rli, qb * 4);
    float g[4];
#pragma unroll
    for (int d0 = 0; d0 < 4; ++d0) g[d0] = P.subln[d0 * 32 + r32] * (1.0f - P.lam_init);
    bf16_t* Ow = P.AO + (rowq + wid * 32 + 4 * hi) * 1024 + h * 128 + r32;
#pragma unroll
    for (int r = 0; r < 16; ++r) {
        float y[4], s = 0.f;
#pragma unroll
        for (int d0 = 0; d0 < 4; ++d0) { y[d0] = st[d0 * 16 + r] - lam * (o[d0][r] * rli[r]); s += y[d0] * y[d0]; }
        s += __shfl_xor(s, 1); s += __shfl_xor(s, 2); s += __shfl_xor(s, 4); s += __shfl_xor(s, 8); s += __shfl_xor(s, 16);
        const float rn = __builtin_amdgcn_rsqf(s * (1.0f / 128.0f) + EPS);
        bf16_t* pr = Ow + ((r & 3) + 8 * (r >> 2)) * 1024; asm volatile("" : "+v"(pr));
#pragma unroll
        for (int d0 = 0; d0 < 4; ++d0) pr[d0 * 32] = att::f2bf(y[d0] * rn * g[d0]);
    }
}

enum { W_IN = 0, W_Q, W_KV, W_O, W_GU, W_D };
__device__ __forceinline__ int map_in(int p) {
    const int pn = p >> 8, bj = (p >> 7) & 1, wc = (p >> 5) & 3, i = p & 31;
    if (pn < 4) return pn * 256 + wc * 64 + bj * 32 + i;
    if (pn < 7) return p;
    if (bj == 0) return wc < 3 ? 1792 + wc * 32 + i : 1920 + i;
    return wc == 0 ? 1888 + i : (wc == 3 ? 1952 + i : -1);
}
__device__ __forceinline__ int map_q(int p) {
    const int pn = p >> 8, bj = (p >> 7) & 1, wc = (p >> 5) & 3, i = p & 31;
    if (pn < 2) return (2 * pn + bj) * 192 + wc * 32 + i;
    return wc * 192 + 128 + bj * 32 + i;
}
__device__ __forceinline__ void prep_item(const float* W, const float* W2, const float* gain, int K, int ldw, int which, bf16_t* dst, int item, int nkb, float* tile) {
    const int tid = ltid(), pb = item / nkb, kb = item % nkb, p0 = pb * 64, k0 = kb * 64;
    const int pp = tid & 63, p = p0 + pp; int lc = p; const float* src = W;
    if (which == W_IN) lc = map_in(p);
    else if (which == W_Q) lc = map_q(p);
    else if (which == W_GU) { lc = (p >> 8) * 128 + (p & 127); if ((p >> 7) & 1) src = W2; }
#pragma unroll
    for (int i = 0; i < 8; ++i) { const int kk = (tid >> 6) + 8 * i; float v = 0.f;
        if (lc >= 0) { v = src[(size_t)(k0 + kk) * ldw + lc]; if (gain) v *= gain[k0 + kk]; }
        tile[kk * 65 + pp] = v; }
    __syncthreads();
    const int pr = tid >> 3, kc = (tid & 7) * 8; const float* s = tile + kc * 65 + pr;
    u32x4 o; o.x = cvt_pk_bf16(s[0], s[65]); o.y = cvt_pk_bf16(s[130], s[195]); o.z = cvt_pk_bf16(s[260], s[325]); o.w = cvt_pk_bf16(s[390], s[455]);
    *(u32x4*)(dst + (size_t)(p0 + pr) * K + k0 + kc) = o;
    __syncthreads();
}

__device__ __forceinline__ void prep_qkv_item(const float* Wq, const float* gq, const float* Wkv, const float* gkv, bf16_t* dst, int item, float* tile) {
    const int tid = ltid(), pb = item / 6, kb = item % 6, p0 = pb * 64, k0 = kb * 64;
    const int pp = tid & 63, p = p0 + pp;
    const bool isq = p0 < 768; const bool live = isq ? (kb < 4) : (kb >= 4);
    const float* src = isq ? Wq : Wkv; const float* gain = isq ? gq : gkv; const int ldw = isq ? 768 : 1024, kof = isq ? 0 : 256, lc = isq ? map_q(p) : p - 768;
#pragma unroll
    for (int i = 0; i < 8; ++i) { const int kk = (tid >> 6) + 8 * i; float v = 0.f;
        if (live) v = src[(size_t)(k0 + kk - kof) * ldw + lc] * gain[k0 + kk - kof];
        tile[kk * 65 + pp] = v; }
    __syncthreads();
    const int pr = tid >> 3, kc = (tid & 7) * 8; const float* t = tile + kc * 65 + pr;
    u32x4 o; o.x = cvt_pk_bf16(t[0], t[65]); o.y = cvt_pk_bf16(t[130], t[195]); o.z = cvt_pk_bf16(t[260], t[325]); o.w = cvt_pk_bf16(t[390], t[455]);
    *(u32x4*)(dst + (size_t)(p0 + pr) * 384 + k0 + kc) = o;
    __syncthreads();
}

__device__ __forceinline__ void absorb_qk(const float* Wqb_all, const float* gq_all, const float* Wkvb_all, const float* gkv_all, unsigned char* ws, int t) {
    const int kb = t & 31, j = (t >> 5) & 127, h = (t >> 12) & 3, l = t >> 14;
    const float* Wqb = Wqb_all + (size_t)l * 256 * 768 + (size_t)(8 * kb) * 768 + 192 * h;
    const float* Wk = Wkvb_all + (size_t)l * 128 * 1024 + (size_t)j * 1024 + 256 * h;
    float acc[8];
#pragma unroll
    for (int kk = 0; kk < 8; ++kk) acc[kk] = 0.f;
#pragma unroll 1
    for (int i = 0; i < 128; i += 4) {
        const f32x4 b = ld4g(Wk + i);
#pragma unroll
        for (int kk = 0; kk < 8; ++kk) { const f32x4 a = ld4g(Wqb + (size_t)kk * 768 + i); acc[kk] += (a[0] * b[0] + a[1] * b[1]) + (a[2] * b[2] + a[3] * b[3]); }
    }
    const float gk = gkv_all[l * 128 + j]; const float* gq = gq_all + l * 256 + 8 * kb;
    bf16_t* dst = (bf16_t*)(ws + WS_W + l * W_LAYER + OW_Q) + (size_t)((h >> 1) * 256 + (h & 1) * 128 + j) * 256 + 8 * kb;
    u32x4 o; o.x = cvt_pk_bf16(acc[0] * gk * gq[0], acc[1] * gk * gq[1]); o.y = cvt_pk_bf16(acc[2] * gk * gq[2], acc[3] * gk * gq[3]);
    o.z = cvt_pk_bf16(acc[4] * gk * gq[4], acc[5] * gk * gq[5]); o.w = cvt_pk_bf16(acc[6] * gk * gq[6], acc[7] * gk * gq[7]);
    *(GAS u32x4*)dst = o;
}
__device__ __forceinline__ void absorb_vo(const float* Wkvb_all, const float* gkv_all, const float* Wo_all, unsigned char* ws, int t) {
    const int n = t & 1023, jb = (t >> 10) & 15, h = (t >> 14) & 3, l = t >> 16;
    const float* Wv = Wkvb_all + (size_t)l * 128 * 1024 + (size_t)(8 * jb) * 1024 + 256 * h + 128;
    const float* Wo = Wo_all + (size_t)l * DM * DM + (size_t)(512 + 128 * h) * DM + n;
    float acc[8];
#pragma unroll
    for (int jj = 0; jj < 8; ++jj) acc[jj] = 0.f;
#pragma unroll 1
    for (int i = 0; i < 128; i += 4) {
        const float b0 = ld1g(Wo + (size_t)i * DM), b1 = ld1g(Wo + (size_t)(i + 1) * DM), b2 = ld1g(Wo + (size_t)(i + 2) * DM), b3 = ld1g(Wo + (size_t)(i + 3) * DM);
#pragma unroll
        for (int jj = 0; jj < 8; ++jj) { const f32x4 a = ld4g(Wv + (size_t)jj * 1024 + i); acc[jj] += (a[0] * b0 + a[1] * b1) + (a[2] * b2 + a[3] * b3); }
    }
    const float* gk = gkv_all + l * 128 + 8 * jb;
    bf16_t* dst = (bf16_t*)(ws + WS_W + l * W_LAYER + OW_O) + (size_t)n * DM + 512 + 128 * h + 8 * jb;
    u32x4 o; o.x = cvt_pk_bf16(acc[0] * gk[0], acc[1] * gk[1]); o.y = cvt_pk_bf16(acc[2] * gk[2], acc[3] * gk[3]);
    o.z = cvt_pk_bf16(acc[4] * gk[4], acc[5] * gk[5]); o.w = cvt_pk_bf16(acc[6] * gk[6], acc[7] * gk[7]);
    *(GAS u32x4*)dst = o;
}
__device__ __forceinline__ float wave_sum(float v) {
#pragma unroll
    for (int o = 1; o < 64; o <<= 1) v += __shfl_xor(v, o);
    return v;
}


#define LAS __attribute__((address_space(3)))
#define XB_TMO      128
#define XB_XCNT(j)  (256  + 64 * (j))
#define XB_XSUB(j)  (1280 + 64 * (j))
#define XB_XGEN(j)  (2304 + 64 * (j))
#define XB_TOP      3328
#define XB_TOPGEN   3392
#define XCD_BAR_WORDS 3456
#define XB_SPIN_CAP (1u << 18)

__device__ __forceinline__ unsigned xb_ld(unsigned* p)              { return __hip_atomic_load(p, __ATOMIC_RELAXED, __HIP_MEMORY_SCOPE_AGENT); }
__device__ __forceinline__ unsigned xb_add(unsigned* p, unsigned v) { return __hip_atomic_fetch_add(p, v, __ATOMIC_RELAXED, __HIP_MEMORY_SCOPE_AGENT); }
__device__ __forceinline__ unsigned xb_xcc_id() { return (unsigned)__builtin_amdgcn_s_getreg((3 << 11) | 20) & 0xFu; }
#define XB_SPIN(cond, bar) do { unsigned _sp = 0; while (cond) { __builtin_amdgcn_s_sleep(1); \
    if ((++_sp & 255u) == 0u) { if (xb_ld(&(bar)[XB_TMO])) break; if (_sp > XB_SPIN_CAP) { atomicAdd(&(bar)[XB_TMO], 1u); break; } } } } while (0)

struct XcdBarrier {
    unsigned* bar; unsigned x;
    volatile LAS unsigned* st;
};

__device__ __forceinline__ XcdBarrier xcd_barrier_post(unsigned* bar, volatile LAS unsigned* st) {
    XcdBarrier b; b.bar = bar; b.x = xb_xcc_id(); b.st = st;
    if (ltid() == 0) (void)xb_add(&bar[XB_XCNT(b.x)], 1u);
    return b;
}
__device__ __forceinline__ void xcd_barrier_complete(unsigned* bar, unsigned x, unsigned& nloc, unsigned& nx) {
    const unsigned G = gridDim.x * gridDim.y * gridDim.z;
    unsigned sum, cnt, mine, sp = 0u;
    for (;;) {
        sum = 0u; cnt = 0u; mine = 0u;
#pragma unroll
        for (unsigned j = 0; j < 16; ++j) { const unsigned c = xb_ld(&bar[XB_XCNT(j)]); sum += c; cnt += (c > 0u) ? 1u : 0u; mine = (j == x) ? c : mine; }
        if (sum == G) break;
        __builtin_amdgcn_s_sleep(1);
        if ((++sp & 255u) == 0u) { if (xb_ld(&bar[XB_TMO])) break; if (sp > XB_SPIN_CAP) { atomicAdd(&bar[XB_TMO], 1u); break; } }
    }
    nloc = mine > 0u ? mine : 1u; nx = cnt > 0u ? cnt : 1u;
}

__device__ __forceinline__ void xcd_barrier(const XcdBarrier& b) {
    asm volatile("s_waitcnt vmcnt(0)" ::: "memory");
    __syncthreads();
    if (ltid() == 0) {
        unsigned* bar = b.bar;
        __builtin_amdgcn_s_waitcnt(0);
        unsigned nloc = b.st[0], nx = b.st[1];
        if (nloc == 0u) { xcd_barrier_complete(bar, b.x, nloc, nx); b.st[0] = nloc; b.st[1] = nx; }
        const unsigned old = xb_add(&bar[XB_XSUB(b.x)], 1u);
        const unsigned gen = old / nloc;
        if (old + 1u == (gen + 1u) * nloc) {
            __builtin_amdgcn_fence(__ATOMIC_RELEASE, "agent");
            asm volatile("s_waitcnt vmcnt(0)" ::: "memory");
            const unsigned og = xb_add(&bar[XB_TOP], 1u);
            const unsigned tg = og / nx;
            if (og + 1u == (tg + 1u) * nx) xb_add(&bar[XB_TOPGEN], 1u);
            else XB_SPIN(xb_ld(&bar[XB_TOPGEN]) == tg, bar);
            __builtin_amdgcn_fence(__ATOMIC_ACQUIRE, "agent");
            xb_add(&bar[XB_XGEN(b.x)], 1u);
            asm volatile("s_waitcnt vmcnt(0)" ::: "memory");
        } else {
            XB_SPIN(xb_ld(&bar[XB_XGEN(b.x)]) == gen, bar);
            __builtin_amdgcn_fence(__ATOMIC_ACQUIRE, "agent");
            asm volatile("s_waitcnt vmcnt(0)" ::: "memory");
        }
    }
    __syncthreads();
}
struct Args { const float* in[19]; float* out; unsigned char* ws; int ph_lo, ph_hi; };
constexpr int PPL = (REPK == -2) ? 6 : 7, PPC = 2 + DEPTH * PPL, NPHASE = 1 + NCH * PPC;

__global__ void __launch_bounds__(NTHR, 2) fwd_kernel(Args args) {
    extern __shared__ __attribute__((aligned(16))) unsigned char lds[];
    PG8_LAS unsigned char* lds3 = (PG8_LAS unsigned char*)lds;
    const int G = gridDim.x, bx = blockIdx.x;
    const int vcu = (G % 8 == 0) ? (bx % 8) * (G / 8) + bx / 8 : bx;
    volatile LAS unsigned* bst = (volatile LAS unsigned*)(lds3 + 131072 + 1024);
    { const int t0 = ltid(); if (t0 < 2) bst[t0] = 0u; }
    __syncthreads();
    (void)xcd_barrier_post((unsigned*)(args.ws + WS_BAR), bst);
    for (int ph = args.ph_lo; ph < args.ph_hi; ++ph) {
    unsigned char* ws = args.ws; asm volatile("" : "+s"(ws));
    const float* rope = (const float*)(ws + WS_ROPE);
    u64* ssq_all = (u64*)(ws + WS_SSQ);
    unsigned char* dob = (unsigned char*)args.out; asm volatile("" : "+s"(dob));
    bf16_t* XB = (bf16_t*)(ws + WS_XB); bf16_t* AO = (bf16_t*)(dob + DO_AO);
    bf16_t* Qd = (bf16_t*)(dob + DO_QD); bf16_t* Kd = (bf16_t*)(dob + DO_KD); bf16_t* Vd = (bf16_t*)(ws + WS_VD);
    bf16_t* CQ = (bf16_t*)(ws + WS_CQ); bf16_t* CKV = nullptr;
    bf16_t* Qm = (bf16_t*)(ws + WS_QM); bf16_t* Km = (bf16_t*)(ws + WS_KM); bf16_t* Vm = (bf16_t*)(ws + WS_VM);
    bf16_t* ACT = (bf16_t*)(ws + WS_ACT);
    {
        if (ph == 0 && (PHMASK & 1)) {
            float* tile = (float*)lds;
            constexpr int nIn = 32 * 16, nQR = 16, nO = 16 * 8, nGU = 88 * 16, nD = 16 * 44, nL = nIn + nQR + nO + nGU + nD;
#pragma unroll 1
            for (int it = bx; it < DEPTH * nL; it += G) {
                const int l = it / nL; int r = it % nL; unsigned char* wl = ws + WS_W + l * W_LAYER;
                if (r < nIn) { prep_item(args.in[3] + (size_t)l * DM * IN_COLS, nullptr, args.in[2] + l * DM, DM, IN_COLS, W_IN, (bf16_t*)(wl + OW_IN), r, 16, tile); continue; } r -= nIn;
                if (r < nQR) { prep_item(args.in[10] + (size_t)l * 256 * 768, nullptr, args.in[9] + l * 256, 256, 768, W_Q, (bf16_t*)(wl + OW_Q), 32 + r, 4, tile); continue; } r -= nQR;
                if (r < nO) { prep_item(args.in[13] + (size_t)l * DM * DM, nullptr, nullptr, DM, DM, W_O, (bf16_t*)(wl + OW_O), (r >> 3) * 16 + (r & 7), 16, tile); continue; } r -= nO;
                if (r < nGU) { prep_item(args.in[15] + (size_t)l * DM * DFF, args.in[16] + (size_t)l * DM * DFF, args.in[14] + l * DM, DM, DFF, W_GU, (bf16_t*)(wl + OW_GU), r, 16, tile); continue; } r -= nGU;
                prep_item(args.in[17] + (size_t)l * DFF * DM, nullptr, nullptr, DFF, DM, W_D, (bf16_t*)(wl + OW_D), r, 44, tile);
            }
#pragma unroll 1
            for (int t = bx * NTHR + ltid(); t < DEPTH * 16384; t += G * NTHR) { asm volatile("" : "+v"(t)); absorb_qk(args.in[10], args.in[9], args.in[12], args.in[11], ws, t); }
#pragma unroll 1
            for (int t = bx * NTHR + ltid(); t < DEPTH * 65536; t += G * NTHR) { asm volatile("" : "+v"(t)); absorb_vo(args.in[12], args.in[11], args.in[13], ws, t); }
#pragma unroll 1
            for (int e = bx * NTHR + ltid(); e < SEQ * 32; e += G * NTHR) { asm volatile("" : "+v"(e));
                const int pos = e >> 5, i = e & 31;
                const float inv = __builtin_amdgcn_exp2f(-(float)i * (13.287712379549449f / 32.0f));
                float t = ((float)pos * inv) * 0.15915494309189535f; t -= floorf(t);
                float* rt = (float*)(ws + WS_ROPE);
                rt[pos * 64 + i] = __builtin_amdgcn_cosf(t); rt[pos * 64 + 32 + i] = __builtin_amdgcn_sinf(t);
            }
#pragma unroll 1
            for (int e = bx * NTHR + ltid(); e < 8 * MTOT; e += G * NTHR) { asm volatile("" : "+v"(e)); ssq_all[MTOT + e] = 0ull; }
        } else {
            const int c = (ph - 1) / PPC, q = (ph - 1) % PPC;
            const int rows = MTOT, rbase = 0, nseq = rows / SEQ; (void)c;
            const float* xin0 = args.in[0]; const float* xin1 = args.in[1] - (size_t)ROWS0 * DM;
            float* outc = args.out + (size_t)rbase * DM;
            if (q == PPC - 1) {
                const int tq = ltid(), lane = tq & 63, wave = __builtin_amdgcn_readfirstlane(tq >> 6);
                const float* gf = args.in[18];
                f32x4 gg[4];
#pragma unroll
                for (int j = 0; j < 4; ++j) gg[j] = ld4g(gf + 4 * lane + 256 * j);
                const u64* ssqf = ssq_all + (size_t)8 * MTOT + rbase;
                const int NGW = G * NWAVES;
                int row = vcu * NWAVES + wave;
#pragma unroll 1
                for (; row < rows; row += 4 * NGW) {
                    unsigned long long v[4][4]; float rs[4];
#pragma unroll
                    for (int b = 0; b < 4; ++b) { const int rr = (row + b * NGW < rows) ? row + b * NGW : row;
                        rs[b] = __builtin_amdgcn_rsqf(ldssq(ssqf + rr) * (1.0f / 1024.0f) + EPS);
                        const GAS unsigned long long* xr = (const GAS unsigned long long*)(XB + (size_t)rr * DM) + lane;
#pragma unroll
                        for (int j = 0; j < 4; ++j) v[b][j] = xr[64 * j]; }
#pragma unroll
                    for (int b = 0; b < 4; ++b) { const int rr = row + b * NGW; if (rr < rows) {
                        float* orow = outc + (size_t)rr * DM + 4 * lane;
#pragma unroll
                        for (int j = 0; j < 4; ++j) { const unsigned lo = (unsigned)v[b][j], hi = (unsigned)(v[b][j] >> 32);
                            const f32x4 x = {__uint_as_float(lo << 16), __uint_as_float(lo & 0xffff0000u), __uint_as_float(hi << 16), __uint_as_float(hi & 0xffff0000u)};
                            st4g(orow + 256 * j, x * rs[b] * gg[j]); } } }
                }
            } else if (q == 0 && (PHMASK & 4)) {
                const int tq = ltid(), lane = tq & 63, wave = __builtin_amdgcn_readfirstlane(tq >> 6);
                u64* ssq0 = ssq_all + rbase;
                const int NGW = G * NWAVES;
                int row = vcu * NWAVES + wave;
#pragma unroll 1
                for (; row + 3 * NGW < rows; row += 4 * NGW) {
                    f32x4 v[4][4];
#pragma unroll
                    for (int b = 0; b < 4; ++b) { const int rq = row + b * NGW; const f32x4* xr = (const f32x4*)((rq < ROWS0 ? xin0 : xin1) + (size_t)rq * DM) + lane;
#pragma unroll
                        for (int j = 0; j < 4; ++j) v[b][j] = xr[64 * j]; }
#pragma unroll
                    for (int b = 0; b < 4; ++b) { const int rr = row + b * NGW;
                        float sm = 0.f; unsigned long long* o8 = (unsigned long long*)(XB + (size_t)rr * DM) + lane;
#pragma unroll
                        for (int j = 0; j < 4; ++j) { const f32x4 w = v[b][j]; sm += (w[0] * w[0] + w[1] * w[1]) + (w[2] * w[2] + w[3] * w[3]);
                            o8[64 * j] = (unsigned long long)cvt_pk_bf16(w[0], w[1]) | ((unsigned long long)cvt_pk_bf16(w[2], w[3]) << 32); }
                        sm = wave_sum(sm);
                        if (lane == 0) ssq0[rr] = (u64)(sm * SSQ_FX); }
                }
#pragma unroll 1
                for (; row < rows; row += NGW) {
                    const f32x4* xr = (const f32x4*)((row < ROWS0 ? xin0 : xin1) + (size_t)row * DM) + lane; float sm = 0.f;
                    unsigned long long* o8 = (unsigned long long*)(XB + (size_t)row * DM) + lane;
#pragma unroll
                    for (int j = 0; j < 4; ++j) { const f32x4 w = xr[64 * j]; sm += (w[0] * w[0] + w[1] * w[1]) + (w[2] * w[2] + w[3] * w[3]);
                        o8[64 * j] = (unsigned long long)cvt_pk_bf16(w[0], w[1]) | ((unsigned long long)cvt_pk_bf16(w[2], w[3]) << 32); }
                    sm = wave_sum(sm);
                    if (lane == 0) ssq0[row] = (u64)(sm * SSQ_FX);
                }
            } else {
                const int l = (q - 1) / PPL, k0 = (q - 1) % PPL, k = (k0 < 6) ? k0 : REPK;
                unsigned char* wl = ws + WS_W + l * W_LAYER;
                const u64* ssq_in = (l == 0) ? ssq_all + rbase : ssq_all + (size_t)(1 + 3) * MTOT + rbase;
                u64* ssq_q = ssq_all + (size_t)(1 + 4 * l + 0) * MTOT + rbase;
                u64* ssq_kv = ssq_all + (size_t)(1 + 4 * l + 1) * MTOT + rbase;
                u64* ssq_ffn = ssq_all + (size_t)(1 + 4 * l + 2) * MTOT + rbase;
                u64* ssq_x = ssq_all + (size_t)(1 + 4 * l + 3) * MTOT + rbase;
                if (k == 0 && (PHMASK & 8)) {
                    pg8::Gemm g{XB, (const bf16_t*)(wl + OW_IN), rows, IN_PHYS, DM}; pg8::StaticOrder S; S.init(rows, IN_PHYS, G, bx);
                    EpiIn E{Qd, Kd, Vd, CQ, CKV, Km, ssq_in, ssq_q, ssq_kv, rope};
                    pg8::gemm_phase<EpiIn, pg8::StaticOrder, PG8_ALIGN, PG8_SP2>(lds3, g, S, E);
                } else if (k == 1 && (PHMASK & 16)) {
                    {
                        const int tq = ltid(), lane = tq & 63, wave = __builtin_amdgcn_readfirstlane(tq >> 6); const int NGW = G * NWAVES;
#pragma unroll 1
                        for (int row = vcu * NWAVES + wave; row < rows; row += 4 * NGW) {
                            unsigned v[4]; float rs[4];
#pragma unroll
                            for (int b = 0; b < 4; ++b) { const int rr = (row + b * NGW < rows) ? row + b * NGW : row;
                                rs[b] = __builtin_amdgcn_rsqf(ldssq(ssq_kv + rr) * (1.0f / 128.0f) + EPS);
                                v[b] = *((const GAS unsigned*)(Km + (size_t)rr * 192) + lane); }
#pragma unroll
                            for (int b = 0; b < 4; ++b) { const int rr = row + b * NGW; if (rr < rows)
                                *((GAS unsigned*)(Km + (size_t)rr * 192) + lane) = cvt_pk_bf16(__uint_as_float(v[b] << 16) * rs[b], __uint_as_float(v[b] & 0xffff0000u) * rs[b]); }
                        }
                    }
                    pg8::Gemm g{CQ, (const bf16_t*)(wl + OW_Q), rows, 768, 256}; pg8::StaticOrder S; S.init(rows, 768, G, bx);
                    EpiQKV E{Qm, Km, Vm, ssq_q, ssq_kv, rope};
                    pg8::gemm_phase<EpiQKV, pg8::StaticOrder, PG8_ALIGN, PG8_SP2>(lds3, g, S, E);
                } else if (k == 2 && (PHMASK & 32)) {
                    const float lam_init = (l == 0) ? 0.2f : 0.35550906759096926f;
                    float s1 = 0.f, s2 = 0.f;
                    for (int i = 0; i < 64; ++i) { s1 += args.in[4][l * 64 + i] * args.in[5][l * 64 + i]; s2 += args.in[6][l * 64 + i] * args.in[7][l * 64 + i]; }
                    const float lam = __expf(s1) - __expf(s2) + lam_init;
                    AttnPtrs P{Qd, Kd, Vd, Qm, Km, Vm, AO, (float*)(ws + WS_STASH), args.in[8] + l * 128, lam_init};
                    const int nU = nseq * 32;
                    for (int u = vcu; u < 2 * nU; u += G) {
                        const int kind = u / nU, v = u % nU, qb = v & 7, h = (v >> 3) & 3, seq = v >> 5;
#if defined(ABL)
                        if (k0 >= 6) { if (kind == 0) mla_unit<ABL>(P, v >> 5, v & 31, (char*)lds); else diff_unit<ABL>(P, seq, h, qb, lam, (char*)lds); } else
#endif
                        { if (kind == 0) { if (PHMASK & 1024) mla_unit<0>(P, v >> 5, v & 31, (char*)lds); } else { if (PHMASK & 2048) diff_unit<0>(P, seq, h, qb, lam, (char*)lds); } }
                    }
                    __syncthreads();
                } else if (k == 3 && (PHMASK & 64)) {
                    pg8::Gemm g{AO, (const bf16_t*)(wl + OW_O), rows, DM, DM}; pg8::StaticOrder S; S.init(rows, DM, G, bx);
                    EpiRes E{XB, ssq_ffn};
                    pg8::gemm_phase<EpiRes, pg8::StaticOrder, PG8_ALIGN, PG8_SP2>(lds3, g, S, E);
                } else if (k == 4 && (PHMASK & 128)) {
                    pg8::Gemm g{XB, (const bf16_t*)(wl + OW_GU), rows, GU_PHYS, DM}; pg8::StaticOrder S; S.init(rows, GU_PHYS, G, bx);
                    EpiGU E{ACT, ssq_ffn};
                    pg8::gemm_phase<EpiGU, pg8::StaticOrder, PG8_ALIGN, PG8_SP2>(lds3, g, S, E);
                } else if (k == 5 && (PHMASK & 256)) {
                    pg8::Gemm g{ACT, (const bf16_t*)(wl + OW_D), rows, DM, DFF}; pg8::StaticOrder S; S.init(rows, DM, G, bx);
                    EpiRes E{XB, ssq_x};
                    pg8::gemm_phase<EpiRes, pg8::StaticOrder, PG8_ALIGN, PG8_SP2>(lds3, g, S, E);
                }
            }
        }
        if (ph + 1 < args.ph_hi && ph != 0) { if (ph == 1) { __threadfence(); cg::this_grid().sync(); } else {
 XcdBarrier xb_; xb_.bar = (unsigned*)(ws + WS_BAR); xb_.x = xb_xcc_id(); xb_.st = (volatile LAS unsigned*)(lds3 + 131072 + 1024); xcd_barrier(xb_); } }
    }
    }
}

extern "C" void kernel_launch(void* const* d_in, const int* in_sizes, int n_in, void* d_out, int out_size, void* d_ws, size_t ws_size, hipStream_t stream) {
    static int grid = 0;
    if (grid == 0) {
        if (n_in != 19 || out_size != MTOT * DM || ws_size < WS_END) { fprintf(stderr, "kernel_launch: unexpected shapes: n_in %d out %d ws %zu (need %zu)\n", n_in, out_size, ws_size, (size_t)WS_END); grid = -1; return; }
        int dev = 0, cus = 0, per_cu = 0;
        if (hipGetDevice(&dev) != hipSuccess || hipDeviceGetAttribute(&cus, hipDeviceAttributeMultiprocessorCount, dev) != hipSuccess) { grid = -1; return; }
        if (hipFuncSetAttribute((const void*)fwd_kernel, hipFuncAttributeMaxDynamicSharedMemorySize, LDS_BYTES) != hipSuccess) { fprintf(stderr, "kernel_launch: hipFuncSetAttribute failed\n"); grid = -1; return; }
        if (hipOccupancyMaxActiveBlocksPerMultiprocessor(&per_cu, (const void*)fwd_kernel, NTHR, LDS_BYTES) != hipSuccess || per_cu < 1) { fprintf(stderr, "kernel_launch: occupancy query says %d blocks per CU\n", per_cu); per_cu = 1; }
        (void)hipGetLastError();
        grid = cus;
    }
    if (grid < 0) return;
    if (hipMemsetAsync((char*)d_ws + WS_BAR, 0, BAR_BYTES, stream) != hipSuccess) { fprintf(stderr, "kernel_launch: memset failed\n"); return; }
    Args a{};
    for (int i = 0; i < 19; ++i) a.in[i] = (const float*)d_in[i];
    a.out = (float*)d_out; a.ws = (unsigned char*)d_ws;
#if defined(MK_MULTI)
    for (int ph = 0; ph < NPHASE; ++ph) { a.ph_lo = ph; a.ph_hi = ph + 1; hipLaunchKernelGGL(fwd_kernel, dim3(grid), dim3(NTHR), LDS_BYTES, stream, a); }
#else
    a.ph_lo = 0; a.ph_hi = NPHASE;
    void* kargs[] = {&a};
    hipError_t e = hipLaunchCooperativeKernel((const void*)fwd_kernel, dim3(grid), dim3(NTHR), kargs, LDS_BYTES, stream);
    if (e != hipSuccess) fprintf(stderr, "kernel_launch: cooperative launch failed: %s (grid %d)\n", hipGetErrorString(e), grid);
#endif
}
```

```cpp
#include <hip/hip_runtime.h>
#include <hip/hip_cooperative_groups.h>
#include <cstdio>
#include <cstdint>
namespace cg = cooperative_groups;
#ifndef PG8_SP2
#define PG8_SP2 true
#endif
#ifndef PG8_ALIGN
#define PG8_ALIGN true
#endif
__device__ __forceinline__ int ltid() { int t = threadIdx.x; asm volatile("" : "+v"(t)); return t; }
namespace pg8 {
#define PG8_LAS __attribute__((address_space(3)))
typedef unsigned short bf16_t;
typedef short bf16x8 __attribute__((ext_vector_type(8)));
typedef float f32x4 __attribute__((ext_vector_type(4)));
typedef unsigned u32x4 __attribute__((ext_vector_type(4)));
constexpr int BM = 256, BK = 64, HALF = 128, HTB = HALF * BK * 2  , STAGE_BYTES = 8 * HTB, NXCD = 8, WGM = 8;

__host__ __device__ __forceinline__ int lds_byte(int r, int c) { const int st = (r >> 4) * 2 + (c >> 5), rr = r & 15, cc = c & 31, ob = rr * 64 + cc * 2; return st * 1024 + (ob ^ (((ob >> 9) & 1) << 5)); }
__host__ __device__ __forceinline__ void stage_rc(int b, int& R, int& C) { const int st = b / 1024, sb = b % 1024, swz = sb ^ (((sb >> 9) & 1) << 5); R = (st >> 1) * 16 + swz / 64; C = (st & 1) * 32 + (swz % 64) / 2; }
__host__ __device__ __forceinline__ int perm32(int rho) { const int n = rho >> 4, i = rho & 15; return 8 * (i >> 2) + 4 * n + (i & 3); }

struct Unit { int pm, pn; };
struct Gemm { const bf16_t* A; const bf16_t* Bt; int M, N, K; };

struct StaticOrder {
    int nM, nN, nwg, G, c;
    __host__ __device__ void init(int M, int N, int G_, int c_) { nM = M / BM; nN = N / BM; nwg = nM * nN; G = G_; c = c_; }
    __host__ __device__ bool next(int i, Unit& u) const {
        const long L = (long)i * G + c; if (L >= nwg) return false;
        int wgid = (int)L; { const int q = nwg / NXCD, r = nwg % NXCD, xcd = wgid % NXCD, off = wgid / NXCD; wgid = (xcd < r ? xcd * (q + 1) : r * (q + 1) + (xcd - r) * q) + off; }
        const int nig = WGM * nN, gid = wgid / nig, fm = gid * WGM, gsz = (nM - fm) < WGM ? (nM - fm) : WGM;
        u.pm = fm + ((wgid % nig) % gsz); u.pn = (wgid % nig) / gsz; return true;
    }
    __device__ __forceinline__ void a_ready(const Unit&) const {}
    __device__ __forceinline__ void done(const Unit&) const {}
};
__device__ __forceinline__ unsigned cvt_pk_bf16(float lo, float hi) { unsigned r; asm volatile("v_cvt_pk_bf16_f32 %0, %1, %2" : "=v"(r) : "v"(lo), "v"(hi)); return r; }
template <class Epi, class Sched, bool ALIGN_EPI = false, bool SP2 = false>
__device__ __forceinline__ void gemm_phase(PG8_LAS unsigned char* lds, const Gemm g, const Sched& S, const Epi& E) {
    const int tid = ltid(), wid = __builtin_amdgcn_readfirstlane(tid >> 6), lane = tid & 63, wr = wid >> 2, wc = wid & 3, fr = lane & 15, fq = lane >> 4;
    const int K = g.K, nt = K / BK;
    unsigned voffA[2], voffB[2];
#pragma unroll
    for (int i = 0; i < 2; ++i) { int R, C; stage_rc(tid * 16 + i * 8192, R, C); const int Rb = Epi::PERM ? ((R & ~31) + perm32(R & 31)) : R;
        voffA[i] = (unsigned)(R * K + C) * 2u; voffB[i] = (unsigned)(Rb * K + C) * 2u; }
    const size_t kstep = (size_t)(BK * 2);
    const size_t hstep = (size_t)HALF * K * 2;
    const size_t tstep = 2 * hstep;
    const unsigned ldsw = (unsigned)wid * 1024u;
    const int aoff = lds_byte(wr * 64 + fr, fq * 8), boff = lds_byte(wc * 32 + fr, fq * 8);
#define PG8_SA(b, h) (((b) * 2 + (h)) * HTB)
#define PG8_SB(b, h) ((4 + (b) * 2 + (h)) * HTB)
#define PG8_STAGE(bufoff, gbase, voff) do { _Pragma("unroll") for (int _i = 0; _i < 2; ++_i) \
        __builtin_amdgcn_global_load_lds((const unsigned*)((const char*)(gbase) + (voff)[_i]), (PG8_LAS unsigned*)(lds + (bufoff) + ldsw + _i * 8192), 16, 0, 0); } while (0)
#define PG8_LDA(dst, b, h) do { _Pragma("unroll") for (int m = 0; m < 4; ++m) _Pragma("unroll") for (int k = 0; k < 2; ++k) dst[m][k] = *(const PG8_LAS bf16x8*)(lds + PG8_SA(b, h) + aoff + m * 2048 + k * 1024); } while (0)
#define PG8_LDB(dst, b, h) do { _Pragma("unroll") for (int n = 0; n < 2; ++n) _Pragma("unroll") for (int k = 0; k < 2; ++k) dst[n][k] = *(const PG8_LAS bf16x8*)(lds + PG8_SB(b, h) + boff + n * 2048 + k * 1024); } while (0)
#define PG8_MMA(ai, bj, At, Bt) do { __builtin_amdgcn_s_setprio(1); _Pragma("unroll") for (int m = 0; m < 4; ++m) _Pragma("unroll") for (int n = 0; n < 2; ++n) _Pragma("unroll") for (int k = 0; k < 2; ++k) \
        acc[ai][bj][m][n] = __builtin_amdgcn_mfma_f32_16x16x32_bf16(Bt[n][k], At[m][k], acc[ai][bj][m][n], 0, 0, 0); __builtin_amdgcn_s_setprio(0); } while (0)
#define PG8_WAIT_V(n) asm volatile("s_waitcnt vmcnt(" #n ")" ::: "memory")
#define PG8_WAIT_L(n) asm volatile("s_waitcnt lgkmcnt(" #n ")" ::: "memory")
#define PG8_BAR __builtin_amdgcn_s_barrier()
#define PG8_SCHED __builtin_amdgcn_sched_barrier(0)
    Unit cur, nxt; int ui = 0;
    if (!S.next(0, cur)) return;
    f32x4 acc[2][2][4][2];
#pragma unroll
    for (int a = 0; a < 2; ++a)
#pragma unroll
        for (int b = 0; b < 2; ++b)
#pragma unroll
            for (int m = 0; m < 4; ++m)
#pragma unroll
                for (int n = 0; n < 2; ++n) acc[a][b][m][n] = (f32x4){0.f, 0.f, 0.f, 0.f};
    bf16x8 At[4][2], B0[2][2], B1[2][2];
    const char* cA = (const char*)g.A + (size_t)cur.pm * tstep; const char* cB = (const char*)g.Bt + (size_t)cur.pn * tstep;
    S.a_ready(cur);
    if constexpr (SP2) {
        PG8_STAGE(PG8_SB(0, 0), cB, voffB); PG8_STAGE(PG8_SB(0, 1), cB + hstep, voffB); PG8_STAGE(PG8_SA(0, 0), cA, voffA); PG8_STAGE(PG8_SA(0, 1), cA + hstep, voffA);
        if (wr == 1) PG8_BAR;
        PG8_WAIT_V(2); PG8_BAR;
        PG8_STAGE(PG8_SB(1, 0), cB + kstep, voffB); PG8_STAGE(PG8_SA(1, 0), cA + kstep, voffA); PG8_STAGE(PG8_SB(1, 1), cB + hstep + kstep, voffB);
        PG8_WAIT_V(6); PG8_BAR;
    } else {
        PG8_STAGE(PG8_SB(0, 0), cB, voffB); PG8_STAGE(PG8_SA(0, 0), cA, voffA); PG8_STAGE(PG8_SB(0, 1), cB + hstep, voffB); PG8_STAGE(PG8_SA(0, 1), cA + hstep, voffA);
        if (wr == 1) PG8_BAR;
        PG8_WAIT_V(4); PG8_BAR;
        PG8_STAGE(PG8_SB(1, 0), cB + kstep, voffB); PG8_STAGE(PG8_SA(1, 0), cA + kstep, voffA); PG8_STAGE(PG8_SB(1, 1), cB + hstep + kstep, voffB);
        PG8_WAIT_V(6); PG8_BAR;
    }
    for (;;) {
        const bool has_next = S.next(ui + 1, nxt);
        const char* nA = has_next ? (const char*)g.A + (size_t)nxt.pm * tstep : cA; const char* nB = has_next ? (const char*)g.Bt + (size_t)nxt.pn * tstep : cB;
        for (int t = 0; t < nt; t += 2) {
            const bool last = (t == nt - 2);
            const char* a1 = cA + (size_t)(t + 1) * kstep;
            const char* a2 = last ? nA : cA + (size_t)(t + 2) * kstep; const char* b2 = last ? nB : cB + (size_t)(t + 2) * kstep;
            const char* a3 = a2 + kstep; const char* b3 = b2 + kstep;
            if (last && has_next) S.a_ready(nxt);
            if constexpr (SP2) {
            PG8_LDB(B0, 0, 0); PG8_LDB(B1, 0, 1); PG8_SCHED; PG8_LDA(At, 0, 0); PG8_STAGE(PG8_SA(1, 1), a1 + hstep, voffA);
            PG8_WAIT_V(8); PG8_WAIT_L(0); PG8_BAR; PG8_MMA(0, 0, At, B0); PG8_MMA(0, 1, At, B1); PG8_BAR; PG8_SCHED;
            PG8_LDA(At, 0, 1); PG8_STAGE(PG8_SB(0, 0), b2, voffB); PG8_STAGE(PG8_SB(0, 1), b2 + hstep, voffB); PG8_STAGE(PG8_SA(0, 0), a2, voffA);
            PG8_WAIT_V(8); PG8_WAIT_L(0); PG8_BAR; PG8_MMA(1, 0, At, B0); PG8_MMA(1, 1, At, B1); PG8_BAR; PG8_SCHED;
            PG8_LDB(B0, 1, 0); PG8_LDB(B1, 1, 1); PG8_SCHED; PG8_LDA(At, 1, 0); PG8_STAGE(PG8_SA(0, 1), a2 + hstep, voffA);
            PG8_WAIT_V(8); PG8_WAIT_L(0); PG8_BAR; PG8_MMA(0, 0, At, B0); PG8_MMA(0, 1, At, B1); PG8_BAR; PG8_SCHED;
            PG8_LDA(At, 1, 1); PG8_STAGE(PG8_SB(1, 0), b3, voffB); PG8_STAGE(PG8_SB(1, 1), b3 + hstep, voffB); PG8_STAGE(PG8_SA(1, 0), a3, voffA);
            PG8_WAIT_V(8); PG8_WAIT_L(0); PG8_BAR; PG8_MMA(1, 0, At, B0); PG8_MMA(1, 1, At, B1); PG8_BAR; PG8_SCHED;
            } else {
            PG8_LDB(B0, 0, 0); PG8_SCHED; PG8_LDA(At, 0, 0); PG8_STAGE(PG8_SA(1, 1), a1 + hstep, voffA);
            PG8_WAIT_L(8); PG8_BAR; PG8_WAIT_L(0); PG8_MMA(0, 0, At, B0); PG8_BAR; PG8_SCHED;
            PG8_LDB(B1, 0, 1); PG8_STAGE(PG8_SB(0, 0), b2, voffB);
            PG8_BAR; PG8_WAIT_L(0); PG8_MMA(0, 1, At, B1); PG8_BAR;
            PG8_LDA(At, 0, 1); PG8_STAGE(PG8_SA(0, 0), a2, voffA);
            PG8_BAR; PG8_WAIT_L(0); PG8_MMA(1, 0, At, B0); PG8_BAR; PG8_SCHED;
            PG8_STAGE(PG8_SB(0, 1), b2 + hstep, voffB);
            PG8_WAIT_V(6); PG8_BAR; PG8_MMA(1, 1, At, B1); PG8_BAR;
            PG8_LDB(B0, 1, 0); PG8_SCHED; PG8_LDA(At, 1, 0); PG8_STAGE(PG8_SA(0, 1), a2 + hstep, voffA);
            PG8_WAIT_L(8); PG8_BAR; PG8_WAIT_L(0); PG8_MMA(0, 0, At, B0); PG8_BAR; PG8_SCHED;
            PG8_LDB(B1, 1, 1); PG8_STAGE(PG8_SB(1, 0), b3, voffB);
            PG8_BAR; PG8_WAIT_L(0); PG8_MMA(0, 1, At, B1); PG8_BAR;
            PG8_LDA(At, 1, 1); PG8_STAGE(PG8_SA(1, 0), a3, voffA);
            PG8_BAR; PG8_WAIT_L(0); PG8_MMA(1, 0, At, B0); PG8_BAR; PG8_SCHED;
            PG8_STAGE(PG8_SB(1, 1), b3 + hstep, voffB);
            PG8_WAIT_V(6); PG8_BAR; PG8_MMA(1, 1, At, B1); PG8_BAR;
            }
        }
        if constexpr (ALIGN_EPI) { if (wr == 0) PG8_BAR; }
        if constexpr (!Epi::AFTER_DRAIN) { E(acc, cur, wr, wc, fr, fq); S.done(cur); }
        if (!has_next) break;
#pragma unroll
        for (int a = 0; a < 2; ++a)
#pragma unroll
            for (int b = 0; b < 2; ++b)
#pragma unroll
                for (int m = 0; m < 4; ++m)
#pragma unroll
                    for (int n = 0; n < 2; ++n) acc[a][b][m][n] = (f32x4){0.f, 0.f, 0.f, 0.f};
        cur = nxt; cA = nA; cB = nB; ++ui;
        if constexpr (ALIGN_EPI) { if (wr == 1) PG8_BAR; }
    }
    PG8_WAIT_V(0);
    if constexpr (!ALIGN_EPI) { if (wr == 0) PG8_BAR; }
    PG8_BAR;
    if constexpr (Epi::AFTER_DRAIN) { E.fused(acc, cur, wr, wc, fr, fq, lds, wid, lane); S.done(cur); }
#undef PG8_SA
#undef PG8_SB
#undef PG8_STAGE
#undef PG8_LDA
#undef PG8_LDB
#undef PG8_MMA
#undef PG8_WAIT_V
#undef PG8_WAIT_L
#undef PG8_BAR
#undef PG8_SCHED
}
}

constexpr int DM = 1024, SEQ = 2048, DEPTH = 2, DFF = 2816;
constexpr int ROWS0 = 16 * 2048, ROWS1 = 32 * 2048, MTOT = ROWS0 + ROWS1, RMAX = MTOT, NCH = 1;
constexpr int IN_COLS = 1984, IN_PHYS = 2048, GU_PHYS = 2 * DFF;
constexpr float EPS = 1e-6f;
constexpr float LOG2E = 1.4426950408889634f;
constexpr float QSCALE_D = 0.125f * LOG2E;
constexpr float QSCALE_M = 0.07216878364870322f * LOG2E;
constexpr int NWAVES = 8, NTHR = 512;
#ifndef REPK
#define REPK -2
#endif
#ifndef PHMASK
#define PHMASK 0xFFFF
#endif

using pg8::bf16_t; using pg8::bf16x8; using pg8::f32x4; using pg8::u32x4; using pg8::Unit; using pg8::cvt_pk_bf16;

constexpr size_t MiB = 1u << 20;
constexpr size_t WS_W = 0, W_LAYER = 25 * MiB;
constexpr size_t OW_IN = 0, OW_Q = 4 * MiB, OW_O = 6 * MiB, OW_GU = 8 * MiB, OW_D = 19 * MiB;
static_assert(OW_Q + 1792 * 384 * 2 <= OW_O && OW_D + (size_t)DM * DFF * 2 <= W_LAYER, "weight map");
constexpr size_t WS_ROPE = 50 * MiB, WS_SSQ = 842 * MiB, WS_BAR = 55 * MiB, BAR_BYTES = 16384, WS_STASH = 56 * MiB;
constexpr size_t WS_XB = 88 * MiB;
constexpr size_t WS_VD = 280 * MiB, WS_CQ = 376 * MiB, WS_QM = 448 * MiB, WS_KM = 592 * MiB, WS_VM = 736 * MiB, WS_END = 850 * MiB;
constexpr size_t WS_ACT = 280 * MiB;
constexpr size_t DO_AO = 0, DO_QD = 192 * MiB, DO_KD = 288 * MiB;
static_assert(WS_ACT + (size_t)RMAX * DFF * 2 <= 832 * MiB && WS_SSQ + (size_t)9 * MTOT * 8 <= WS_END && WS_XB + (size_t)MTOT * DM * 2 <= WS_VD, "workspace map");
constexpr int LDS_BYTES = 135168;

#define GAS __attribute__((address_space(1)))
__device__ __forceinline__ void st8(bf16_t* p, f32x4 a, f32x4 b) {
    u32x4 w; w.x = cvt_pk_bf16(a[0], a[1]); w.y = cvt_pk_bf16(a[2], a[3]); w.z = cvt_pk_bf16(b[0], b[1]); w.w = cvt_pk_bf16(b[2], b[3]);
    *(GAS u32x4*)p = w;
}
__device__ __forceinline__ f32x4 ld4g(const float* p) { return *(const GAS f32x4*)p; }
__device__ __forceinline__ float ld1g(const float* p) { return *(const GAS float*)p; }
__device__ __forceinline__ void st4g(float* p, f32x4 v) { *(GAS f32x4*)p = v; }
typedef unsigned long long u64;
constexpr float SSQ_FX = 16777216.0f, SSQ_IFX = 1.0f / 16777216.0f;
__device__ __forceinline__ void atomg(u64* p, float v) { (void)__hip_atomic_fetch_add((GAS u64*)p, (u64)(v * SSQ_FX), __ATOMIC_RELAXED, __HIP_MEMORY_SCOPE_AGENT); }
__device__ __forceinline__ float ldssq(const u64* p) { return (float)(*(const GAS u64*)p) * SSQ_IFX; }
__device__ __forceinline__ float sq8(f32x4 a, f32x4 b) { return (a[0] * a[0] + a[1] * a[1]) + (a[2] * a[2] + a[3] * a[3]) + (b[0] * b[0] + b[1] * b[1]) + (b[2] * b[2] + b[3] * b[3]); }
__device__ __forceinline__ float red_fq(float s) { s += __shfl_xor(s, 16); s += __shfl_xor(s, 32); return s; }
__device__ __forceinline__ void rope8r(f32x4 c0, f32x4 c1, f32x4 s0, f32x4 s1, f32x4& a0, f32x4& a1, f32x4& b0, f32x4& b1) {
    const f32x4 x0 = a0 * c0 - b0 * s0, x1 = a1 * c1 - b1 * s1, y0 = b0 * c0 + a0 * s0, y1 = b1 * c1 + a1 * s1;
    a0 = x0; a1 = x1; b0 = y0; b1 = y1;
}

struct EpiIn {
    static constexpr bool PERM = true, AFTER_DRAIN = false;
    bf16_t *Qd, *Kd, *Vd, *CQ, *CKV, *Km; const u64* ssq_in; u64* ssq_q; u64* ssq_kv; const float* rope;
    __device__ __forceinline__ void operator()(const f32x4 (&acc)[2][2][4][2], const Unit& u, int wr, int wc, int fr, int fq) const {
        { const int ln_ = ltid() & 63; fr = ln_ & 15; fq = ln_ >> 4; }
        const int pn = u.pn;
        const bool roped = (pn < 4) || (pn == 7 && wc == 3);
        const int row0 = u.pm * 256 + wr * 64 + fr;
        float rs[4][2]; f32x4 tb[4][2][4];
        f32x4 v[4][2][4];
#define EPI_ROW(b, mm) (row0 + ((b) >> 1) * 128 + (2 * ((b) & 1) + (mm)) * 16)
#define EPI_IN_LOAD(b) do { _Pragma("unroll") for (int mm = 0; mm < 2; ++mm) { const int row = EPI_ROW(b, mm); rs[b][mm] = ldssq(ssq_in + row); \
            if (roped) { const float* tab = rope + (row & (SEQ - 1)) * 64 + 8 * fq; tb[b][mm][0] = ld4g(tab); tb[b][mm][1] = ld4g(tab + 4); tb[b][mm][2] = ld4g(tab + 32); tb[b][mm][3] = ld4g(tab + 36); } } } while (0)
#define EPI_IN_COMP(b) do { _Pragma("unroll") for (int mm = 0; mm < 2; ++mm) { const float r = __builtin_amdgcn_rsqf(rs[b][mm] * (1.0f / 1024.0f) + EPS) * ((pn < 2) ? QSCALE_D : 1.0f); \
            const int ai = (b) >> 1, m = 2 * ((b) & 1) + mm; \
            v[b][mm][0] = acc[ai][0][m][0] * r; v[b][mm][1] = acc[ai][0][m][1] * r; v[b][mm][2] = acc[ai][1][m][0] * r; v[b][mm][3] = acc[ai][1][m][1] * r; \
            if (roped) rope8r(tb[b][mm][0], tb[b][mm][1], tb[b][mm][2], tb[b][mm][3], v[b][mm][0], v[b][mm][1], v[b][mm][2], v[b][mm][3]); } } while (0)
#define EPI_IN_STORE(b) do { _Pragma("unroll") for (int mm = 0; mm < 2; ++mm) { const int row = EPI_ROW(b, mm); \
            const f32x4 a0 = v[b][mm][0], a1 = v[b][mm][1], b0 = v[b][mm][2], b1 = v[b][mm][3]; \
            if (pn < 4) { bf16_t* dst = (pn < 2 ? Qd : Kd) + (size_t)row * 512 + (pn & 1) * 256 + wc * 64 + 8 * fq; st8(dst, a0, a1); st8(dst + 32, b0, b1); } \
            else if (pn < 6) { bf16_t* dst = Vd + (size_t)row * 512 + (pn - 4) * 256 + wc * 32 + 8 * fq; st8(dst, a0, a1); st8(dst + 128, b0, b1); } \
            else if (pn == 6) { bf16_t* dst = CQ + (size_t)row * 256 + wc * 32 + 8 * fq; st8(dst, a0, a1); st8(dst + 128, b0, b1); \
                const float s = red_fq(sq8(a0, a1) + sq8(b0, b1)); if (fq == 0) atomg(ssq_q + row, s); } \
            else if (wc < 3) { st8(Km + (size_t)row * 192 + wc * 32 + 8 * fq, a0, a1); float s = sq8(a0, a1); \
                if (wc == 0) { st8(Km + (size_t)row * 192 + 96 + 8 * fq, b0, b1); s += sq8(b0, b1); } \
                s = red_fq(s); if (fq == 0) atomg(ssq_kv + row, s); } \
            else { bf16_t* dst = Km + (size_t)row * 192 + 128 + 8 * fq; st8(dst, a0, a1); st8(dst + 32, b0, b1); } } } while (0)
        EPI_IN_LOAD(0); EPI_IN_COMP(0); EPI_IN_LOAD(1); EPI_IN_STORE(0); EPI_IN_COMP(1); EPI_IN_LOAD(2); EPI_IN_STORE(1); EPI_IN_COMP(2); EPI_IN_LOAD(3); EPI_IN_STORE(2); EPI_IN_COMP(3); EPI_IN_STORE(3);
#undef EPI_IN_LOAD
#undef EPI_IN_COMP
#undef EPI_IN_STORE
    }
};

struct EpiQKV {
    static constexpr bool PERM = true, AFTER_DRAIN = false;
    bf16_t *Qm, *Km, *Vm; const u64 *ssq_q, *ssq_kv; const float* rope;
    __device__ __forceinline__ void operator()(const f32x4 (&acc)[2][2][4][2], const Unit& u, int wr, int wc, int fr, int fq) const {
        const int pn = u.pn;
        const u64* ssq = pn < 3 ? ssq_q : ssq_kv; const float invk = pn < 3 ? (1.0f / 256.0f) : (1.0f / 128.0f), sc = pn < 3 ? QSCALE_M : 1.0f;
        char* d0; char* d1; unsigned ld0, ld1;
        if (pn < 2) { d0 = (char*)(Qm + (2 * pn) * 192 + wc * 32); d1 = d0 + 192 * 2; ld0 = ld1 = 768 * 2; }
        else if (pn == 2) { d0 = (char*)(Qm + wc * 192 + 128); d1 = d0 + 32 * 2; ld0 = ld1 = 768 * 2; }
        else { d0 = (char*)(Km + (pn - 3) * 192 + wc * 32); d1 = (char*)(Vm + (pn - 3) * 128 + wc * 32); ld0 = 768 * 2; ld1 = 512 * 2; }
        { const int ln_ = ltid() & 63; fr = ln_ & 15; fq = ln_ >> 4; }
        const unsigned row0 = u.pm * 256 + wr * 64 + fr, lo = 16 * fq;
#pragma unroll
        for (int ai = 0; ai < 2; ++ai)
#pragma unroll
            for (int m = 0; m < 4; ++m) {
                const unsigned row = row0 + ai * 128 + m * 16;
                const float r = __builtin_amdgcn_rsqf(ldssq(ssq + row) * invk + EPS) * sc;
                f32x4 a0 = acc[ai][0][m][0] * r, a1 = acc[ai][0][m][1] * r, b0 = acc[ai][1][m][0] * r, b1 = acc[ai][1][m][1] * r;
                if (pn == 2) { const float* tab = rope + (row & (SEQ - 1)) * 64 + 8 * fq; rope8r(ld4g(tab), ld4g(tab + 4), ld4g(tab + 32), ld4g(tab + 36), a0, a1, b0, b1); }
                st8((bf16_t*)(d0 + (row * ld0 + lo)), a0, a1); st8((bf16_t*)(d1 + (row * ld1 + lo)), b0, b1);
            }
#define EPI_Q_LOAD(b)
#define EPI_Q_COMP(b)
#define EPI_Q_STORE(b)
#undef EPI_Q_LOAD
#undef EPI_Q_COMP
#undef EPI_Q_STORE
    }
};

struct EpiRes {
    static constexpr bool PERM = true, AFTER_DRAIN = false;
    bf16_t* X; u64* ssq_out;
    __device__ __forceinline__ void operator()(const f32x4 (&acc)[2][2][4][2], const Unit& u, int wr, int wc, int fr, int fq) const {
        { const int ln_ = ltid() & 63; fr = ln_ & 15; fq = ln_ >> 4; }
        const size_t off0 = (size_t)(u.pm * 256 + wr * 64 + fr) * 1024 + u.pn * 256 + wc * 32 + 8 * fq;
        const int row0 = u.pm * 256 + wr * 64 + fr;
        u32x4 xin[2][4][2];
        f32x4 v[2][4][2][2];
#define EPI_R_LOAD(ai) do { _Pragma("unroll") for (int m = 0; m < 4; ++m) _Pragma("unroll") for (int bj = 0; bj < 2; ++bj) \
            xin[ai][m][bj] = *(const GAS u32x4*)(X + off0 + (size_t)((ai) * 128 + m * 16) * 1024 + bj * 128); } while (0)
#define EPI_R_COMP(ai) do { _Pragma("unroll") for (int m = 0; m < 4; ++m) _Pragma("unroll") for (int bj = 0; bj < 2; ++bj) { const u32x4 w = xin[ai][m][bj]; \
            const f32x4 x0 = {__uint_as_float(w.x << 16), __uint_as_float(w.x & 0xffff0000u), __uint_as_float(w.y << 16), __uint_as_float(w.y & 0xffff0000u)}; \
            const f32x4 x1 = {__uint_as_float(w.z << 16), __uint_as_float(w.z & 0xffff0000u), __uint_as_float(w.w << 16), __uint_as_float(w.w & 0xffff0000u)}; \
            v[ai][m][bj][0] = x0 + acc[ai][bj][m][0]; v[ai][m][bj][1] = x1 + acc[ai][bj][m][1]; } } while (0)
#define EPI_R_STORE(ai) do { _Pragma("unroll") for (int m = 0; m < 4; ++m) { float s = 0.f; const int rr = (ai) * 128 + m * 16; \
            _Pragma("unroll") for (int bj = 0; bj < 2; ++bj) { st8(X + off0 + (size_t)rr * 1024 + bj * 128, v[ai][m][bj][0], v[ai][m][bj][1]); s += sq8(v[ai][m][bj][0], v[ai][m][bj][1]); } \
            s = red_fq(s); if (fq == 0) atomg(ssq_out + row0 + rr, s); } } while (0)
        EPI_R_LOAD(0); EPI_R_LOAD(1); EPI_R_COMP(0); EPI_R_STORE(0); EPI_R_COMP(1); EPI_R_STORE(1);
#undef EPI_R_LOAD
#undef EPI_R_COMP
#undef EPI_R_STORE
    }
};

struct EpiGU {
    static constexpr bool PERM = true, AFTER_DRAIN = false;
    bf16_t* ACT; const u64* ssq_ffn;
    __device__ __forceinline__ void operator()(const f32x4 (&acc)[2][2][4][2], const Unit& u, int wr, int wc, int fr, int fq) const {
        { const int ln_ = ltid() & 63; fr = ln_ & 15; fq = ln_ >> 4; }
        const int row0 = u.pm * 256 + wr * 64 + fr;
        float rs[2][4];
#pragma unroll
        for (int ai = 0; ai < 2; ++ai)
#pragma unroll
            for (int m = 0; m < 4; ++m) rs[ai][m] = ldssq(ssq_ffn + row0 + ai * 128 + m * 16);
#pragma unroll
        for (int ai = 0; ai < 2; ++ai)
#pragma unroll
            for (int m = 0; m < 4; ++m) {
                const int row = row0 + ai * 128 + m * 16;
                const float r = __builtin_amdgcn_rsqf(rs[ai][m] * (1.0f / 1024.0f) + EPS);
                f32x4 o[2];
#pragma unroll
                for (int n = 0; n < 2; ++n) {
                    const f32x4 g = acc[ai][0][m][n] * r, up = acc[ai][1][m][n] * r;
#pragma unroll
                    for (int j = 0; j < 4; ++j) { const float e = __builtin_amdgcn_exp2f(-g[j] * LOG2E); o[n][j] = g[j] * up[j] * __builtin_amdgcn_rcpf(1.0f + e); }
                }
                st8(ACT + (size_t)row * DFF + u.pn * 128 + wc * 32 + 8 * fq, o[0], o[1]);
            }
    }
};

namespace att {
typedef short s16x4 __attribute__((ext_vector_type(4)));
typedef float f32x16 __attribute__((ext_vector_type(16)));
constexpr int KVBLK = 64, SHM_V = 16384, LDS_V = 0, LDS_K = 32768, SHM_KMAX = 24576, LDS_WS = LDS_K + 2 * SHM_KMAX;
constexpr float THR_L2 = 11.5f;
#define SBAR() __builtin_amdgcn_sched_barrier(0)
__device__ __forceinline__ int crow(int r, int hi) { return (r & 3) + 8 * (r >> 2) + 4 * hi; }
__device__ __forceinline__ unsigned cvtpk(float lo, float hi) { unsigned r; asm volatile("v_cvt_pk_bf16_f32 %0, %1, %2" : "=v"(r) : "v"(lo), "v"(hi)); return r; }

__device__ __forceinline__ void partialSM(f32x16& p0, f32x16& p1, float& m_reg, float& mn, float& alpha, bool first) {
    float pmax = p0[0];
#pragma unroll
    for (int r = 1; r < 16; ++r) pmax = fmaxf(pmax, p0[r]);
#pragma unroll
    for (int r = 0; r < 16; ++r) pmax = fmaxf(pmax, p1[r]);
    { auto rr = __builtin_amdgcn_permlane32_swap(__float_as_uint(pmax), __float_as_uint(pmax), false, false);
      pmax = fmaxf(__uint_as_float(rr[0]), __uint_as_float(rr[1])); }
    if (__builtin_expect(!first && __all(pmax <= THR_L2), 1)) { mn = m_reg; alpha = 1.f; }
    else { const float d = first ? pmax : fmaxf(pmax, 0.f); mn = m_reg + d; alpha = first ? 0.f : __builtin_amdgcn_exp2f(-d); m_reg = mn;
#pragma unroll
        for (int r = 0; r < 16; ++r) p0[r] = p0[r] - d;
#pragma unroll
        for (int r = 0; r < 16; ++r) p1[r] = p1[r] - d; }
#pragma unroll
    for (int r = 0; r < 16; ++r) p0[r] = __builtin_amdgcn_exp2f(p0[r]);
}
__device__ __forceinline__ void finishSM(f32x16& p0, f32x16& p1, float alpha, float& l_reg, bf16x8& pa0, bf16x8& pa1, bf16x8& pa2, bf16x8& pa3) {
#pragma unroll
    for (int r = 0; r < 16; ++r) p1[r] = __builtin_amdgcn_exp2f(p1[r]);
    float ps = 0;
#pragma unroll
    for (int r = 0; r < 16; ++r) ps += p0[r];
#pragma unroll
    for (int r = 0; r < 16; ++r) ps += p1[r];
    { auto rr = __builtin_amdgcn_permlane32_swap(__float_as_uint(ps), __float_as_uint(ps), false, false);
      ps = __uint_as_float(rr[0]) + __uint_as_float(rr[1]); }
    l_reg = l_reg * alpha + ps;
#define PK4(P, BASE, OUT) do { unsigned a0 = cvtpk(P[BASE + 0], P[BASE + 1]), a1 = cvtpk(P[BASE + 2], P[BASE + 3]);   \
    unsigned b0 = cvtpk(P[BASE + 4], P[BASE + 5]), b1 = cvtpk(P[BASE + 6], P[BASE + 7]);                              \
    auto r0 = __builtin_amdgcn_permlane32_swap(a0, b0, false, false); auto r1 = __builtin_amdgcn_permlane32_swap(a1, b1, false, false); \
    u32x4 w = {r0[0], r1[0], r0[1], r1[1]}; OUT = *reinterpret_cast<bf16x8*>(&w); } while (0)
    PK4(p0, 0, pa0); PK4(p0, 8, pa1); PK4(p1, 0, pa2); PK4(p1, 8, pa3);
#undef PK4
}
__device__ __forceinline__ void finishLite(f32x16& p0, f32x16& p1, bf16x8& pa0, bf16x8& pa1, bf16x8& pa2, bf16x8& pa3) {
#define PK4(P, BASE, OUT) do { unsigned a0 = cvtpk(P[BASE + 0], P[BASE + 1]), a1 = cvtpk(P[BASE + 2], P[BASE + 3]);   \
    unsigned b0 = cvtpk(P[BASE + 4], P[BASE + 5]), b1 = cvtpk(P[BASE + 6], P[BASE + 7]);                              \
    auto r0 = __builtin_amdgcn_permlane32_swap(a0, b0, false, false); auto r1 = __builtin_amdgcn_permlane32_swap(a1, b1, false, false); \
    u32x4 w = {r0[0], r1[0], r0[1], r1[1]}; OUT = *reinterpret_cast<bf16x8*>(&w); } while (0)
    PK4(p0, 0, pa0); PK4(p0, 8, pa1); PK4(p1, 0, pa2); PK4(p1, 8, pa3);
#undef PK4
}
template <int DQK>
__device__ __forceinline__ void qkt(f32x16& p0, f32x16& p1, const char* Ks, const bf16x8* qr, int r32, int hi, float negm) {
    constexpr int KROWB = DQK * 2;
#pragma unroll
    for (int r = 0; r < 16; ++r) { p0[r] = negm; p1[r] = negm; }
    const int sw = ((r32 >> 1) & 7) << 4;
#pragma unroll
    for (int d0 = 0; d0 < DQK / 16; ++d0) { const int cb = (d0 * 16 + hi * 8) * 2;
        bf16x8 b0 = *reinterpret_cast<const bf16x8*>(Ks + r32 * KROWB + (cb ^ sw));
        bf16x8 b1 = *reinterpret_cast<const bf16x8*>(Ks + (32 + r32) * KROWB + (cb ^ sw));
        p0 = __builtin_amdgcn_mfma_f32_32x32x16_bf16(b0, qr[d0], p0, 0, 0, 0);
        p1 = __builtin_amdgcn_mfma_f32_32x32x16_bf16(b1, qr[d0], p1, 0, 0, 0); }
}
__device__ __forceinline__ int v_st(int k, int c) { const int kk = (k & ~0xC) | ((k & 4) << 1) | ((k & 8) >> 1); return ((kk >> 3) * 4 + (c >> 5)) * 512 + ((kk & 7) * 32 + (c & 31)) * 2; }
__device__ __forceinline__ int v_rd_base(int lane) { return ((lane & 3) << 3) | (((lane >> 2) & 3) << 6) | (((lane >> 4) & 1) << 5) | (((lane >> 5) & 1) << 8); }
#define TK(j_) ((((j_) + rot) & (SEQ / KVBLK - 1)) * KVBLK)
constexpr int v_rd_off(int d0, int ks, int half) { return d0 * 512 + ks * 4096 + half * 2048; }
template <int OFF> __device__ __forceinline__ s16x4 tr_read(int vb) {
    s16x4 r; asm volatile("ds_read_b64_tr_b16 %0, %1 offset:%2" : "=&v"(r) : "v"(vb), "i"(OFF) : "memory"); return r;
}
struct VFrag { s16x4 l0, h0, l1, h1, l2, h2, l3, h3; };
template <int D0> __device__ __forceinline__ void v_reads(VFrag& f, int vb) {
    f.l0 = tr_read<v_rd_off(D0, 0, 0)>(vb); f.h0 = tr_read<v_rd_off(D0, 0, 1)>(vb); f.l1 = tr_read<v_rd_off(D0, 1, 0)>(vb); f.h1 = tr_read<v_rd_off(D0, 1, 1)>(vb);
    f.l2 = tr_read<v_rd_off(D0, 2, 0)>(vb); f.h2 = tr_read<v_rd_off(D0, 2, 1)>(vb); f.l3 = tr_read<v_rd_off(D0, 3, 0)>(vb); f.h3 = tr_read<v_rd_off(D0, 3, 1)>(vb);
}
__device__ __forceinline__ void pv_mma(f32x16& od, const VFrag& f, bf16x8 pa0, bf16x8 pa1, bf16x8 pa2, bf16x8 pa3) {
#define PK(L, H) (bf16x8){L[0], L[1], L[2], L[3], H[0], H[1], H[2], H[3]}
    od = __builtin_amdgcn_mfma_f32_32x32x16_bf16(pa0, PK(f.l0, f.h0), od, 0, 0, 0);
    od = __builtin_amdgcn_mfma_f32_32x32x16_bf16(pa1, PK(f.l1, f.h1), od, 0, 0, 0);
    od = __builtin_amdgcn_mfma_f32_32x32x16_bf16(pa2, PK(f.l2, f.h2), od, 0, 0, 0);
    od = __builtin_amdgcn_mfma_f32_32x32x16_bf16(pa3, PK(f.l3, f.h3), od, 0, 0, 0);
#undef PK
}
__device__ __forceinline__ void pv_d0(f32x16* o, int vb, bf16x8 pa0, bf16x8 pa1, bf16x8 pa2, bf16x8 pa3) {
    VFrag fa, fb;
    v_reads<0>(fa, vb); v_reads<1>(fb, vb);
    asm volatile("s_waitcnt lgkmcnt(8)" ::: "memory"); SBAR(); pv_mma(o[0], fa, pa0, pa1, pa2, pa3);
    v_reads<2>(fa, vb);
    asm volatile("s_waitcnt lgkmcnt(8)" ::: "memory"); SBAR(); pv_mma(o[1], fb, pa0, pa1, pa2, pa3);
    v_reads<3>(fb, vb);
    asm volatile("s_waitcnt lgkmcnt(8)" ::: "memory"); SBAR(); pv_mma(o[2], fa, pa0, pa1, pa2, pa3);
    asm volatile("s_waitcnt lgkmcnt(0)" ::: "memory"); SBAR(); pv_mma(o[3], fb, pa0, pa1, pa2, pa3);
}

template <int D0> __device__ __forceinline__ void pv_one_s(f32x16& od, int vb, bf16x8 pa0, bf16x8 pa1, bf16x8 pa2, bf16x8 pa3) {
    VFrag f; v_reads<D0>(f, vb);
    asm volatile("s_waitcnt lgkmcnt(0)" ::: "memory"); SBAR();
    pv_mma(od, f, pa0, pa1, pa2, pa3);
}
template <bool DB> __device__ __forceinline__ void pv_sel(f32x16* o, int vb, bf16x8 pa0, bf16x8 pa1, bf16x8 pa2, bf16x8 pa3) {
    if constexpr (DB) pv_d0(o, vb, pa0, pa1, pa2, pa3);
    else { pv_one_s<0>(o[0], vb, pa0, pa1, pa2, pa3); pv_one_s<1>(o[1], vb, pa0, pa1, pa2, pa3); pv_one_s<2>(o[2], vb, pa0, pa1, pa2, pa3); pv_one_s<3>(o[3], vb, pa0, pa1, pa2, pa3); }
}

template <int DQK, int ldq, int ldk, int ldv, int VAR>
__device__ __forceinline__ void attn_core(const bf16_t* __restrict__ Qb, const bf16_t* __restrict__ Kh,
                                          const bf16_t* __restrict__ Vh, char* lds, f32x16 (&o)[4], float (&rli)[16], int rot) {
    constexpr int ND = DQK / 16, KROWB = DQK * 2, SHM_K = 64 * KROWB, NKC = DQK / 64, CPR = DQK / 8;
    const int tid = ltid(), wid = tid >> 6, lane = tid & 63, r32 = lane & 31, hi = lane >> 5;
    char* V_lds = lds + LDS_V; char* K_lds = lds + LDS_K;
    float* ws = (float*)(lds + LDS_WS) + wid * 64; float* li_l = ws; float* al_l = ws + 32;
    float m_reg = 0.f, l_reg = 0;
#pragma unroll
    for (int d = 0; d < 4; ++d) o[d] = f32x16{};
    bf16x8 qr[ND];
    const bf16_t* Qw = Qb + (size_t)(wid * 32 + r32) * ldq + hi * 8;
#pragma unroll
    for (int d0 = 0; d0 < ND; ++d0) qr[d0] = *reinterpret_cast<const bf16x8*>(Qw + d0 * 16);
    const int sr = tid >> 4, sc = (tid & 15) * 8, vst0 = v_st(sr, sc), vst1 = v_st(32 + sr, sc);
    int kg_off[NKC], kl_off[NKC];
#pragma unroll
    for (int i = 0; i < NKC; ++i) { const int cid = tid + 512 * i, kr = cid / CPR, kc = cid % CPR; kg_off[i] = kr * ldk + kc * 8; kl_off[i] = kr * KROWB + ((kc * 16) ^ (((kr >> 1) & 7) << 4)); }
    const int vb0 = (int)(uintptr_t)V_lds + v_rd_base(lane);
    bf16x8 vs0, vs1, ks[NKC];
#define SLOAD(k0) do { if constexpr (VAR == 4) break; vs0 = *reinterpret_cast<const bf16x8*>(&Vh[(size_t)((k0) + sr) * ldv + sc]); vs1 = *reinterpret_cast<const bf16x8*>(&Vh[(size_t)((k0) + 32 + sr) * ldv + sc]); \
    _Pragma("unroll") for (int i_ = 0; i_ < NKC; ++i_) ks[i_] = *reinterpret_cast<const bf16x8*>(&Kh[(size_t)(k0) * ldk + kg_off[i_]]); } while (0)
#define SWRITE(b) do { if constexpr (VAR == 4) break; *(bf16x8*)(V_lds + (b) * SHM_V + vst0) = vs0; *(bf16x8*)(V_lds + (b) * SHM_V + vst1) = vs1; \
    _Pragma("unroll") for (int i_ = 0; i_ < NKC; ++i_) *(bf16x8*)(K_lds + (b) * SHM_K + kl_off[i_]) = ks[i_]; } while (0)
#define SWAIT() asm volatile("s_waitcnt vmcnt(0)" ::: "memory")
#define RESC(a) do { if (__any((a) < 1.f)) { if (hi == 0) al_l[r32] = (a); asm volatile("s_waitcnt lgkmcnt(0)" ::: "memory"); \
    _Pragma("unroll") for (int d = 0; d < 4; ++d) _Pragma("unroll") for (int r = 0; r < 16; ++r) o[d][r] *= al_l[crow(r, hi)]; } } while (0)
    f32x16 pA0, pA1, pB0, pB1; float mnA, mnB, alA, alB; bf16x8 pa0, pa1, pa2, pa3; constexpr int NT = SEQ / KVBLK;
    __syncthreads();
    SLOAD(TK(0)); SWAIT(); SWRITE(0); __syncthreads();
    do { if constexpr (VAR != 3) qkt<DQK>(pA0, pA1, K_lds, qr, r32, hi, -m_reg); else { pA0 = f32x16{}; pA1 = f32x16{}; } } while (0); do { if constexpr (VAR != 1) partialSM(pA0, pA1, m_reg, mnA, alA, true); else { mnA = m_reg; alA = 1.f; } } while (0);
    SLOAD(TK(1));
    SWAIT(); SWRITE(1); __syncthreads();
#pragma unroll 1
    for (int j = 1; j + 1 < NT; j += 2) {
        SBAR(); do { if constexpr (VAR != 3) qkt<DQK>(pB0, pB1, K_lds + SHM_K, qr, r32, hi, -m_reg); else { pB0 = f32x16{}; pB1 = f32x16{}; } } while (0);
        do { if constexpr (VAR != 1) finishSM(pA0, pA1, alA, l_reg, pa0, pa1, pa2, pa3); else finishLite(pA0, pA1, pa0, pa1, pa2, pa3); } while (0); SBAR();
        SLOAD(TK(j + 1)); SBAR();
        do { if constexpr (VAR != 2) pv_d0(o, vb0, pa0, pa1, pa2, pa3); } while (0); do { if constexpr (VAR != 1) partialSM(pB0, pB1, m_reg, mnB, alB, false); else { mnB = m_reg; alB = 1.f; } } while (0);
        __syncthreads(); SWAIT(); SWRITE(0);
        RESC(alB); __syncthreads();
        SBAR(); do { if constexpr (VAR != 3) qkt<DQK>(pA0, pA1, K_lds, qr, r32, hi, -m_reg); else { pA0 = f32x16{}; pA1 = f32x16{}; } } while (0);
        do { if constexpr (VAR != 1) finishSM(pB0, pB1, alB, l_reg, pa0, pa1, pa2, pa3); else finishLite(pB0, pB1, pa0, pa1, pa2, pa3); } while (0); SBAR();
        SLOAD(TK(j + 2)); SBAR();
        do { if constexpr (VAR != 2) pv_d0(o, vb0 + SHM_V, pa0, pa1, pa2, pa3); } while (0); do { if constexpr (VAR != 1) partialSM(pA0, pA1, m_reg, mnA, alA, false); else { mnA = m_reg; alA = 1.f; } } while (0);
        __syncthreads(); SWAIT(); SWRITE(1);
        RESC(alA); __syncthreads();
    }
    SBAR(); do { if constexpr (VAR != 3) qkt<DQK>(pB0, pB1, K_lds + SHM_K, qr, r32, hi, -m_reg); else { pB0 = f32x16{}; pB1 = f32x16{}; } } while (0);
    do { if constexpr (VAR != 1) finishSM(pA0, pA1, alA, l_reg, pa0, pa1, pa2, pa3); else finishLite(pA0, pA1, pa0, pa1, pa2, pa3); } while (0); SBAR();
    do { if constexpr (VAR != 2) pv_d0(o, vb0, pa0, pa1, pa2, pa3); } while (0); do { if constexpr (VAR != 1) partialSM(pB0, pB1, m_reg, mnB, alB, false); else { mnB = m_reg; alB = 1.f; } } while (0);
    __syncthreads(); RESC(alB);
    do { if constexpr (VAR != 1) finishSM(pB0, pB1, alB, l_reg, pa0, pa1, pa2, pa3); else finishLite(pB0, pB1, pa0, pa1, pa2, pa3); } while (0); SBAR();
    do { if constexpr (VAR != 2) pv_d0(o, vb0 + SHM_V, pa0, pa1, pa2, pa3); } while (0);
    if (hi == 0) li_l[r32] = l_reg; asm volatile("s_waitcnt lgkmcnt(0)" ::: "memory");
#pragma unroll
    for (int r = 0; r < 16; ++r) rli[r] = __builtin_amdgcn_rcpf(li_l[crow(r, hi)]);
#undef SLOAD
#undef SWRITE
#undef SWAIT
#undef RESC
}

template <int DQK, int ldq, int ldk, int ldv, int VAR, bool MQA>
__device__ __forceinline__ void attn_core1(const bf16_t* __restrict__ Qb, const bf16_t* __restrict__ Kh,
                                           const bf16_t* __restrict__ Vh, char* lds, f32x16 (&o)[4], float (&rli)[16], int rot) {
    constexpr int ND = DQK / 16, KROWB = DQK * 2, SHM_K = 64 * KROWB, NKC = DQK / 64, CPR = DQK / 8;
    const int tid = ltid(), wid = tid >> 6, lane = tid & 63, r32 = lane & 31, hi = lane >> 5;
    char* V_lds = lds + LDS_V; char* K_lds = lds + LDS_K;
    float* ws = (float*)(lds + LDS_WS) + wid * 64; float* li_l = ws; float* al_l = ws + 32;
    float m_reg = 0.f, l_reg = 0;
#pragma unroll
    for (int d = 0; d < 4; ++d) o[d] = f32x16{};
    bf16x8 qr[ND];
    const bf16_t* Qw = MQA ? Qb + (size_t)((wid & 1) * 32 + r32) * ldq + (wid >> 1) * DQK + hi * 8 : Qb + (size_t)(wid * 32 + r32) * ldq + hi * 8;
#pragma unroll
    for (int d0 = 0; d0 < ND; ++d0) qr[d0] = *reinterpret_cast<const bf16x8*>(Qw + d0 * 16);
    const int sr = tid >> 4, sc = (tid & 15) * 8, vst0 = v_st(sr, sc), vst1 = v_st(32 + sr, sc);
    int kg_off[NKC], kl_off[NKC];
#pragma unroll
    for (int i = 0; i < NKC; ++i) { const int cid = tid + 512 * i, kr = cid / CPR, kc = cid % CPR; kg_off[i] = kr * ldk + kc * 8; kl_off[i] = kr * KROWB + ((kc * 16) ^ (((kr >> 1) & 7) << 4)); }
    const int vb0 = (int)(uintptr_t)V_lds + v_rd_base(lane);
    bf16x8 vs0, vs1, ks[NKC];
#define SLOAD(k0) do { if constexpr (VAR == 4) break; vs0 = *reinterpret_cast<const bf16x8*>(&Vh[(size_t)((k0) + sr) * ldv + sc]); vs1 = *reinterpret_cast<const bf16x8*>(&Vh[(size_t)((k0) + 32 + sr) * ldv + sc]); \
    _Pragma("unroll") for (int i_ = 0; i_ < NKC; ++i_) ks[i_] = *reinterpret_cast<const bf16x8*>(&Kh[(size_t)(k0) * ldk + kg_off[i_]]); } while (0)
#define SWRITE(b) do { if constexpr (VAR == 4) break; *(bf16x8*)(V_lds + (b) * SHM_V + vst0) = vs0; *(bf16x8*)(V_lds + (b) * SHM_V + vst1) = vs1; \
    _Pragma("unroll") for (int i_ = 0; i_ < NKC; ++i_) *(bf16x8*)(K_lds + (b) * SHM_K + kl_off[i_]) = ks[i_]; } while (0)
#define SWAIT() asm volatile("s_waitcnt vmcnt(0)" ::: "memory")
#define RESC(a) do { if (__any((a) < 1.f)) { if (hi == 0) al_l[r32] = (a); asm volatile("s_waitcnt lgkmcnt(0)" ::: "memory"); \
    _Pragma("unroll") for (int d = 0; d < 4; ++d) _Pragma("unroll") for (int r = 0; r < 16; ++r) o[d][r] *= al_l[crow(r, hi)]; } } while (0)
    f32x16 p0, p1; float mn, al; bf16x8 pa0, pa1, pa2, pa3; constexpr int NT = SEQ / KVBLK;
    __syncthreads();
    SLOAD(TK(0)); SWAIT(); SWRITE(0); SLOAD(TK(1)); __syncthreads();
#pragma unroll 1
    for (int j = 0; j < NT; ++j) {
        const int cur = j & 1;
        SBAR(); do { if constexpr (VAR != 3) qkt<DQK>(p0, p1, K_lds + cur * SHM_K, qr, r32, hi, -m_reg); else { p0 = f32x16{}; p1 = f32x16{}; } } while (0);
        if (j + 1 < NT) { SWAIT(); SWRITE(cur ^ 1); }
        if (j + 2 < NT) SLOAD(TK(j + 2));
        SBAR();
        do { if constexpr (VAR != 1) partialSM(p0, p1, m_reg, mn, al, j == 0); else { mn = m_reg; al = 1.f; } } while (0); RESC(al);
        do { if constexpr (VAR != 1) finishSM(p0, p1, al, l_reg, pa0, pa1, pa2, pa3); else finishLite(p0, p1, pa0, pa1, pa2, pa3); } while (0); SBAR();
        do { if constexpr (VAR != 2) pv_d0(o, vb0 + cur * SHM_V, pa0, pa1, pa2, pa3); } while (0);
        __syncthreads();
    }
    if (hi == 0) li_l[r32] = l_reg; asm volatile("s_waitcnt lgkmcnt(0)" ::: "memory");
#pragma unroll
    for (int r = 0; r < 16; ++r) rli[r] = __builtin_amdgcn_rcpf(li_l[crow(r, hi)]);
#undef SLOAD
#undef SWRITE
#undef SWAIT
#undef RESC
}


template <int OFF> __device__ __forceinline__ u32x4 k_read(int addr) {
    u32x4 r; asm volatile("ds_read_b128 %0, %1 offset:%2" : "=&v"(r) : "v"(addr), "i"(OFF) : "memory"); return r;
}
template <int DQK, int D0> __device__ __forceinline__ void qk_issue(const int (&ad)[4], u32x4& y0, u32x4& y1) {
    constexpr int A = (D0 >> 2) * 128, B = D0 & 3;
    y0 = k_read<A>(ad[B]); y1 = k_read<A + 32 * DQK * 2>(ad[B]);
}
template <int DQK, int D0> __device__ __forceinline__ void qk_step(f32x16& p0, f32x16& p1, const int (&ad)[4], const bf16x8* qr, u32x4& c0, u32x4& c1) {
    constexpr int ND = DQK / 16;
    if constexpr (D0 < ND) {
        if constexpr (D0 + 1 < ND) asm volatile("s_waitcnt lgkmcnt(2)" ::: "memory"); else asm volatile("s_waitcnt lgkmcnt(0)" ::: "memory");
        SBAR();
        p0 = __builtin_amdgcn_mfma_f32_32x32x16_bf16(__builtin_bit_cast(bf16x8, c0), qr[D0], p0, 0, 0, 0);
        p1 = __builtin_amdgcn_mfma_f32_32x32x16_bf16(__builtin_bit_cast(bf16x8, c1), qr[D0], p1, 0, 0, 0);
        if constexpr (D0 + 2 < ND) qk_issue<DQK, D0 + 2>(ad, c0, c1);
    }
}
template <int DQK>
__device__ __forceinline__ void qkt_p(f32x16& p0, f32x16& p1, int kbase, const bf16x8* qr, int r32, int hi, float negm) {
    static_assert(DQK / 16 <= 12 && DQK / 16 >= 2, "k-steps");
#pragma unroll
    for (int r = 0; r < 16; ++r) { p0[r] = negm; p1[r] = negm; }
    const int sw = ((r32 >> 1) & 7) << 4, rowb = kbase + r32 * (DQK * 2);
    int ad[4];
#pragma unroll
    for (int b = 0; b < 4; ++b) ad[b] = rowb + ((b * 32 + hi * 16) ^ sw);
    u32x4 xa0, xa1, xb0, xb1;
    qk_issue<DQK, 0>(ad, xa0, xa1); qk_issue<DQK, 1>(ad, xb0, xb1);
    qk_step<DQK, 0>(p0, p1, ad, qr, xa0, xa1); qk_step<DQK, 1>(p0, p1, ad, qr, xb0, xb1);
    qk_step<DQK, 2>(p0, p1, ad, qr, xa0, xa1); qk_step<DQK, 3>(p0, p1, ad, qr, xb0, xb1);
    qk_step<DQK, 4>(p0, p1, ad, qr, xa0, xa1); qk_step<DQK, 5>(p0, p1, ad, qr, xb0, xb1);
    qk_step<DQK, 6>(p0, p1, ad, qr, xa0, xa1); qk_step<DQK, 7>(p0, p1, ad, qr, xb0, xb1);
    qk_step<DQK, 8>(p0, p1, ad, qr, xa0, xa1); qk_step<DQK, 9>(p0, p1, ad, qr, xb0, xb1);
    qk_step<DQK, 10>(p0, p1, ad, qr, xa0, xa1); qk_step<DQK, 11>(p0, p1, ad, qr, xb0, xb1);
}

template <int DQK, int ldq, int ldk, int ldv, int VAR, bool MQA>
__device__ __forceinline__ void attn_core1d(const bf16_t* __restrict__ Qb, const bf16_t* __restrict__ Kh,
                                            const bf16_t* __restrict__ Vh, char* lds, f32x16 (&o)[4], float (&rli)[16], int rot) {
    constexpr int ND = DQK / 16, KROWB = DQK * 2, SHM_K = 64 * KROWB, NKP = SHM_K / 8192;
    const int tid = ltid(), wid = tid >> 6, lane = tid & 63, r32 = lane & 31, hi = lane >> 5;
    const int widu = __builtin_amdgcn_readfirstlane(wid);
    char* V_lds = lds + LDS_V; char* K_lds = lds + LDS_K;
    float* ws = (float*)(lds + LDS_WS) + wid * 64; float* li_l = ws; float* al_l = ws + 32;
    float m_reg = 0.f, l_reg = 0;
#pragma unroll
    for (int d = 0; d < 4; ++d) o[d] = f32x16{};
    bf16x8 qr[ND];
    const bf16_t* Qw = MQA ? Qb + (size_t)((wid & 1) * 32 + r32) * ldq + (wid >> 1) * DQK + hi * 8 : Qb + (size_t)(wid * 32 + r32) * ldq + hi * 8;
#pragma unroll
    for (int d0 = 0; d0 < ND; ++d0) qr[d0] = *reinterpret_cast<const bf16x8*>(Qw + d0 * 16);
    int kgo[NKP], vgo[2];
#pragma unroll
    for (int i = 0; i < NKP; ++i) { const int b = (widu + 8 * i) * 1024 + 16 * lane, kr = b / KROWB, cs = (b % KROWB) >> 4, c = (cs & ~7) | ((cs & 7) ^ ((kr >> 1) & 7)); kgo[i] = kr * ldk + c * 8; }
#pragma unroll
    for (int i = 0; i < 2; ++i) { const int b = (widu + 8 * i) * 1024 + 16 * lane, st = b >> 9, w2 = (b & 511) >> 1, kk = (st >> 2) * 8 + (w2 >> 5), k = (kk & ~0xC) | ((kk & 4) << 1) | ((kk & 8) >> 1), c = (st & 3) * 32 + (w2 & 31); vgo[i] = k * ldv + c; }
    const int vb0 = (int)(uintptr_t)V_lds + v_rd_base(lane), kb0 = (int)(uintptr_t)K_lds;
    PG8_LAS unsigned char* lds3 = (PG8_LAS unsigned char*)lds;
#define DMA(k0, buf) do { if constexpr (VAR == 4) break; \
    _Pragma("unroll") for (int i_ = 0; i_ < NKP; ++i_) __builtin_amdgcn_global_load_lds((const unsigned*)(Kh + (size_t)(k0) * ldk + kgo[i_]), (PG8_LAS unsigned*)(lds3 + LDS_K + (buf) * SHM_K + (widu + 8 * i_) * 1024), 16, 0, 0); \
    _Pragma("unroll") for (int i_ = 0; i_ < 2; ++i_) __builtin_amdgcn_global_load_lds((const unsigned*)(Vh + (size_t)(k0) * ldv + vgo[i_]), (PG8_LAS unsigned*)(lds3 + LDS_V + (buf) * SHM_V + (widu + 8 * i_) * 1024), 16, 0, 0); } while (0)
#define RESC(a) do { if (__any((a) < 1.f)) { if (hi == 0) al_l[r32] = (a); asm volatile("s_waitcnt lgkmcnt(0)" ::: "memory"); \
    _Pragma("unroll") for (int d = 0; d < 4; ++d) _Pragma("unroll") for (int r = 0; r < 16; ++r) o[d][r] *= al_l[crow(r, hi)]; } } while (0)
    f32x16 p0, p1; float mn, al; bf16x8 pa0, pa1, pa2, pa3; constexpr int NT = SEQ / KVBLK;
    __syncthreads();
    DMA(TK(0), 0); asm volatile("s_waitcnt vmcnt(0)" ::: "memory"); __syncthreads();
#pragma unroll 1
    for (int j = 0; j < NT; ++j) {
        const int cur = j & 1;
        if (j + 1 < NT) DMA(TK(j + 1), cur ^ 1);
        SBAR(); do { if constexpr (VAR != 3) qkt_p<DQK>(p0, p1, kb0 + cur * SHM_K, qr, r32, hi, -m_reg); else { p0 = f32x16{}; p1 = f32x16{}; } } while (0);
        do { if constexpr (VAR != 1) partialSM(p0, p1, m_reg, mn, al, j == 0); else { mn = m_reg; al = 1.f; } } while (0); RESC(al);
        do { if constexpr (VAR != 1) finishSM(p0, p1, al, l_reg, pa0, pa1, pa2, pa3); else finishLite(p0, p1, pa0, pa1, pa2, pa3); } while (0); SBAR();
        do { if constexpr (VAR != 2) pv_d0(o, vb0 + cur * SHM_V, pa0, pa1, pa2, pa3); } while (0);
        asm volatile("s_waitcnt vmcnt(0)" ::: "memory");
        __syncthreads();
    }
    if (hi == 0) li_l[r32] = l_reg; asm volatile("s_waitcnt lgkmcnt(0)" ::: "memory");
#pragma unroll
    for (int r = 0; r < 16; ++r) rli[r] = __builtin_amdgcn_rcpf(li_l[crow(r, hi)]);
#undef DMA
#undef RESC
}
__device__ __forceinline__ bf16_t f2bf(float x) { return (bf16_t)(cvtpk(x, x) & 0xffffu); }
}

struct AttnPtrs { const bf16_t *Qd, *Kd, *Vd, *Qm, *Km, *Vm; bf16_t* AO; float* stash; const float* subln; float lam_init; };

template <int VAR> __device__ __forceinline__ void mla_unit(const AttnPtrs& P, int seq, int qb64, char* lds) {
    const int tid = ltid(), wid = tid >> 6, lane = tid & 63, r32 = lane & 31, hi = lane >> 5;
    const size_t rowq = (size_t)seq * SEQ + qb64 * 64, rowk = (size_t)seq * SEQ;
    att::f32x16 o[4]; float rli[16];
    att::attn_core1d<192, 768, 192, 192, VAR, true>(P.Qm + rowq * 768, P.Km + rowk * 192, P.Km + rowk * 192, lds, o, rli, (qb64 & 7) * 4);
    bf16_t* Ow = P.AO + (rowq + (wid & 1) * 32 + 4 * hi) * 1024 + 512 + (wid >> 1) * 128 + r32;
#pragma unroll
    for (int r = 0; r < 16; ++r) { bf16_t* pr = Ow + ((r & 3) + 8 * (r >> 2)) * 1024; asm volatile("" : "+v"(pr));
#pragma unroll
        for (int d0 = 0; d0 < 4; ++d0) pr[d0 * 32] = att::f2bf(o[d0][r] * rli[r]); }
}

template <int VAR> __device__ __forceinline__ void diff_unit(const AttnPtrs& P, int seq, int h, int qb, float lam, char* lds) {
    const int tid = ltid(), wid = tid >> 6, lane = tid & 63, r32 = lane & 31, hi = lane >> 5;
    const size_t rowq = (size_t)seq * SEQ + qb * 256, rowk = (size_t)seq * SEQ;
    float* st = P.stash + (size_t)blockIdx.x * 32768 + tid * 64;
    att::f32x16 o[4]; float rli[16];
    att::attn_core1d<64, 512, 512, 512, VAR, false>(P.Qd + rowq * 512 + (2 * h) * 64, P.Kd + rowk * 512 + (2 * h) * 64, P.Vd + rowk * 512 + h * 128, lds, o, rli, qb * 4);
#pragma unroll
    for (int d0 = 0; d0 < 4; ++d0)
#pragma unroll
        for (int r = 0; r < 16; r += 4) *(f32x4*)(st + d0 * 16 + r) = (f32x4){o[d0][r] * rli[r], o[d0][r + 1] * rli[r + 1], o[d0][r + 2] * rli[r + 2], o[d0][r + 3] * rli[r + 3]};
    att::attn_core1d<64, 512, 512, 512, VAR, false>(P.Qd + rowq * 512 + (2 * h + 1) * 64, P.Kd + rowk * 512 + (2 * h + 1) * 64, P.Vd + rowk * 512 + h * 128, lds, o, rli, qb * 4);
    float g[4];
#pragma unroll
    for (int d0 = 0; d0 < 4; ++d0) g[d0] = P.subln[d0 * 32 + r32] * (1.0f - P.lam_init);
    bf16_t* Ow = P.AO + (rowq + wid * 32 + 4 * hi) * 1024 + h * 128 + r32;
#pragma unroll
    for (int r = 0; r < 16; ++r) {
        float y[4], s = 0.f;
#pragma unroll
        for (int d0 = 0; d0 < 4; ++d0) { y[d0] = st[d0 * 16 + r] - lam * (o[d0][r] * rli[r]); s += y[d0] * y[d0]; }
        s += __shfl_xor(s, 1); s += __shfl_xor(s, 2); s += __shfl_xor(s, 4); s += __shfl_xor(s, 8); s += __shfl_xor(s, 16);
        const float rn = __builtin_amdgcn_rsqf(s * (1.0f / 128.0f) + EPS);
        bf16_t* pr = Ow + ((r & 3) + 8 * (r >> 2)) * 1024; asm volatile("" : "+v"(pr));
#pragma unroll
        for (int d0 = 0; d0 < 4; ++d0) pr[d0 * 32] = att::f2bf(y[d0] * rn * g[d0]);
    }
}

enum { W_IN = 0, W_Q, W_KV, W_O, W_GU, W_D };
__device__ __forceinline__ int map_in(int p) {
    const int pn = p >> 8, bj = (p >> 7) & 1, wc = (p >> 5) & 3, i = p & 31;
    if (pn < 4) return pn * 256 + wc * 64 + bj * 32 + i;
    if (pn < 7) return p;
    if (bj == 0) return wc < 3 ? 1792 + wc * 32 + i : 1920 + i;
    return wc == 0 ? 1888 + i : (wc == 3 ? 1952 + i : -1);
}
__device__ __forceinline__ int map_q(int p) {
    const int pn = p >> 8, bj = (p >> 7) & 1, wc = (p >> 5) & 3, i = p & 31;
    if (pn < 2) return (2 * pn + bj) * 192 + wc * 32 + i;
    return wc * 192 + 128 + bj * 32 + i;
}
__device__ __forceinline__ void prep_item(const float* W, const float* W2, const float* gain, int K, int ldw, int which, bf16_t* dst, int item, int nkb, float* tile) {
    const int tid = ltid(), pb = item / nkb, kb = item % nkb, p0 = pb * 64, k0 = kb * 64;
    const int pp = tid & 63, p = p0 + pp; int lc = p; const float* src = W;
    if (which == W_IN) lc = map_in(p);
    else if (which == W_Q) lc = map_q(p);
    else if (which == W_GU) { lc = (p >> 8) * 128 + (p & 127); if ((p >> 7) & 1) src = W2; }
#pragma unroll
    for (int i = 0; i < 8; ++i) { const int kk = (tid >> 6) + 8 * i; float v = 0.f;
        if (lc >= 0) { v = src[(size_t)(k0 + kk) * ldw + lc]; if (gain) v *= gain[k0 + kk]; }
        tile[kk * 65 + pp] = v; }
    __syncthreads();
    const int pr = tid >> 3, kc = (tid & 7) * 8; const float* s = tile + kc * 65 + pr;
    u32x4 o; o.x = cvt_pk_bf16(s[0], s[65]); o.y = cvt_pk_bf16(s[130], s[195]); o.z = cvt_pk_bf16(s[260], s[325]); o.w = cvt_pk_bf16(s[390], s[455]);
    *(u32x4*)(dst + (size_t)(p0 + pr) * K + k0 + kc) = o;
    __syncthreads();
}

__device__ __forceinline__ void prep_qkv_item(const float* Wq, const float* gq, const float* Wkv, const float* gkv, bf16_t* dst, int item, float* tile) {
    const int tid = ltid(), pb = item / 6, kb = item % 6, p0 = pb * 64, k0 = kb * 64;
    const int pp = tid & 63, p = p0 + pp;
    const bool isq = p0 < 768; const bool live = isq ? (kb < 4) : (kb >= 4);
    const float* src = isq ? Wq : Wkv; const float* gain = isq ? gq : gkv; const int ldw = isq ? 768 : 1024, kof = isq ? 0 : 256, lc = isq ? map_q(p) : p - 768;
#pragma unroll
    for (int i = 0; i < 8; ++i) { const int kk = (tid >> 6) + 8 * i; float v = 0.f;
        if (live) v = src[(size_t)(k0 + kk - kof) * ldw + lc] * gain[k0 + kk - kof];
        tile[kk * 65 + pp] = v; }
    __syncthreads();
    const int pr = tid >> 3, kc = (tid & 7) * 8; const float* t = tile + kc * 65 + pr;
    u32x4 o; o.x = cvt_pk_bf16(t[0], t[65]); o.y = cvt_pk_bf16(t[130], t[195]); o.z = cvt_pk_bf16(t[260], t[325]); o.w = cvt_pk_bf16(t[390], t[455]);
    *(u32x4*)(dst + (size_t)(p0 + pr) * 384 + k0 + kc) = o;
    __syncthreads();
}

__device__ __forceinline__ void absorb_qk(const float* Wqb_all, const float* gq_all, const float* Wkvb_all, const float* gkv_all, unsigned char* ws, int t) {
    const int kb = t & 31, j = (t >> 5) & 127, h = (t >> 12) & 3, l = t >> 14;
    const float* Wqb = Wqb_all + (size_t)l * 256 * 768 + (size_t)(8 * kb) * 768 + 192 * h;
    const float* Wk = Wkvb_all + (size_t)l * 128 * 1024 + (size_t)j * 1024 + 256 * h;
    float acc[8];
#pragma unroll
    for (int kk = 0; kk < 8; ++kk) acc[kk] = 0.f;
#pragma unroll 4
    for (int i = 0; i < 128; i += 4) {
        const f32x4 b = ld4g(Wk + i);
#pragma unroll
        for (int kk = 0; kk < 8; ++kk) { const f32x4 a = ld4g(Wqb + (size_t)kk * 768 + i); acc[kk] += (a[0] * b[0] + a[1] * b[1]) + (a[2] * b[2] + a[3] * b[3]); }
    }
    const float gk = gkv_all[l * 128 + j]; const float* gq = gq_all + l * 256 + 8 * kb;
    bf16_t* dst = (bf16_t*)(ws + WS_W + l * W_LAYER + OW_Q) + (size_t)((h >> 1) * 256 + (h & 1) * 128 + j) * 256 + 8 * kb;
    u32x4 o; o.x = cvt_pk_bf16(acc[0] * gk * gq[0], acc[1] * gk * gq[1]); o.y = cvt_pk_bf16(acc[2] * gk * gq[2], acc[3] * gk * gq[3]);
    o.z = cvt_pk_bf16(acc[4] * gk * gq[4], acc[5] * gk * gq[5]); o.w = cvt_pk_bf16(acc[6] * gk * gq[6], acc[7] * gk * gq[7]);
    *(GAS u32x4*)dst = o;
}
__device__ __forceinline__ void absorb_vo(const float* Wkvb_all, const float* gkv_all, const float* Wo_all, unsigned char* ws, int t) {
    const int n = t & 1023, jb = (t >> 10) & 15, h = (t >> 14) & 3, l = t >> 16;
    const float* Wv = Wkvb_all + (size_t)l * 128 * 1024 + (size_t)(8 * jb) * 1024 + 256 * h + 128;
    const float* Wo = Wo_all + (size_t)l * DM * DM + (size_t)(512 + 128 * h) * DM + n;
    float acc[8];
#pragma unroll
    for (int jj = 0; jj < 8; ++jj) acc[jj] = 0.f;
#pragma unroll 4
    for (int i = 0; i < 128; i += 4) {
        const float b0 = ld1g(Wo + (size_t)i * DM), b1 = ld1g(Wo + (size_t)(i + 1) * DM), b2 = ld1g(Wo + (size_t)(i + 2) * DM), b3 = ld1g(Wo + (size_t)(i + 3) * DM);
#pragma unroll
        for (int jj = 0; jj < 8; ++jj) { const f32x4 a = ld4g(Wv + (size_t)jj * 1024 + i); acc[jj] += (a[0] * b0 + a[1] * b1) + (a[2] * b2 + a[3] * b3); }
    }
    const float* gk = gkv_all + l * 128 + 8 * jb;
    bf16_t* dst = (bf16_t*)(ws + WS_W + l * W_LAYER + OW_O) + (size_t)n * DM + 512 + 128 * h + 8 * jb;
    u32x4 o; o.x = cvt_pk_bf16(acc[0] * gk[0], acc[1] * gk[1]); o.y = cvt_pk_bf16(acc[2] * gk[2], acc[3] * gk[3]);
    o.z = cvt_pk_bf16(acc[4] * gk[4], acc[5] * gk[5]); o.w = cvt_pk_bf16(acc[6] * gk[6], acc[7] * gk[7]);
    *(GAS u32x4*)dst = o;
}
__device__ __forceinline__ float wave_sum(float v) {
#pragma unroll
    for (int o = 1; o < 64; o <<= 1) v += __shfl_xor(v, o);
    return v;
}


#define LAS __attribute__((address_space(3)))
#define XB_TMO      128
#define XB_XCNT(j)  (256  + 64 * (j))
#define XB_XSUB(j)  (1280 + 64 * (j))
#define XB_XGEN(j)  (2304 + 64 * (j))
#define XB_TOP      3328
#define XB_TOPGEN   3392
#define XCD_BAR_WORDS 3456
#define XB_SPIN_CAP (1u << 18)

__device__ __forceinline__ unsigned xb_ld(unsigned* p)              { return __hip_atomic_load(p, __ATOMIC_RELAXED, __HIP_MEMORY_SCOPE_AGENT); }
__device__ __forceinline__ unsigned xb_add(unsigned* p, unsigned v) { return __hip_atomic_fetch_add(p, v, __ATOMIC_RELAXED, __HIP_MEMORY_SCOPE_AGENT); }
__device__ __forceinline__ unsigned xb_xcc_id() { return (unsigned)__builtin_amdgcn_s_getreg((3 << 11) | 20) & 0xFu; }
#define XB_SPIN(cond, bar) do { unsigned _sp = 0; while (cond) { __builtin_amdgcn_s_sleep(1); \
    if ((++_sp & 255u) == 0u) { if (xb_ld(&(bar)[XB_TMO])) break; if (_sp > XB_SPIN_CAP) { atomicAdd(&(bar)[XB_TMO], 1u); break; } } } } while (0)

struct XcdBarrier {
    unsigned* bar; unsigned x;
    volatile LAS unsigned* st;
};

__device__ __forceinline__ XcdBarrier xcd_barrier_post(unsigned* bar, volatile LAS unsigned* st) {
    XcdBarrier b; b.bar = bar; b.x = xb_xcc_id(); b.st = st;
    if (ltid() == 0) (void)xb_add(&bar[XB_XCNT(b.x)], 1u);
    return b;
}
__device__ __forceinline__ void xcd_barrier_complete(unsigned* bar, unsigned x, unsigned& nloc, unsigned& nx) {
    const unsigned G = gridDim.x * gridDim.y * gridDim.z;
    unsigned sum, cnt, mine, sp = 0u;
    for (;;) {
        sum = 0u; cnt = 0u; mine = 0u;
#pragma unroll
        for (unsigned j = 0; j < 16; ++j) { const unsigned c = xb_ld(&bar[XB_XCNT(j)]); sum += c; cnt += (c > 0u) ? 1u : 0u; mine = (j == x) ? c : mine; }
        if (sum == G) break;
        __builtin_amdgcn_s_sleep(1);
        if ((++sp & 255u) == 0u) { if (xb_ld(&bar[XB_TMO])) break; if (sp > XB_SPIN_CAP) { atomicAdd(&bar[XB_TMO], 1u); break; } }
    }
    nloc = mine > 0u ? mine : 1u; nx = cnt > 0u ? cnt : 1u;
}

__device__ __forceinline__ void xcd_barrier(const XcdBarrier& b) {
    asm volatile("s_waitcnt vmcnt(0)" ::: "memory");
    __syncthreads();
    if (ltid() == 0) {
        unsigned* bar = b.bar;
        __builtin_amdgcn_s_waitcnt(0);
        unsigned nloc = b.st[0], nx = b.st[1];
        if (nloc == 0u) { xcd_barrier_complete(bar, b.x, nloc, nx); b.st[0] = nloc; b.st[1] = nx; }
        const unsigned old = xb_add(&bar[XB_XSUB(b.x)], 1u);
        const unsigned gen = old / nloc;
        if (old + 1u == (gen + 1u) * nloc) {
            __builtin_amdgcn_fence(__ATOMIC_RELEASE, "agent");
            asm volatile("s_waitcnt vmcnt(0)" ::: "memory");
            const unsigned og = xb_add(&bar[XB_TOP], 1u);
            const unsigned tg = og / nx;
            if (og + 1u == (tg + 1u) * nx) xb_add(&bar[XB_TOPGEN], 1u);
            else XB_SPIN(xb_ld(&bar[XB_TOPGEN]) == tg, bar);
            __builtin_amdgcn_fence(__ATOMIC_ACQUIRE, "agent");
            xb_add(&bar[XB_XGEN(b.x)], 1u);
            asm volatile("s_waitcnt vmcnt(0)" ::: "memory");
        } else {
            XB_SPIN(xb_ld(&bar[XB_XGEN(b.x)]) == gen, bar);
            __builtin_amdgcn_fence(__ATOMIC_ACQUIRE, "agent");
            asm volatile("s_waitcnt vmcnt(0)" ::: "memory");
        }
    }
    __syncthreads();
}
struct Args { const float* in[19]; float* out; unsigned char* ws; int ph_lo, ph_hi; };
constexpr int PPL = (REPK == -2) ? 6 : 7, PPC = 2 + DEPTH * PPL, NPHASE = 1 + NCH * PPC;

__global__ void __launch_bounds__(NTHR, 2) fwd_kernel(Args args) {
    extern __shared__ __attribute__((aligned(16))) unsigned char lds[];
    PG8_LAS unsigned char* lds3 = (PG8_LAS unsigned char*)lds;
    const int G = gridDim.x, bx = blockIdx.x;
    const int vcu = (G % 8 == 0) ? (bx % 8) * (G / 8) + bx / 8 : bx;
    volatile LAS unsigned* bst = (volatile LAS unsigned*)(lds3 + 131072 + 1024);
    { const int t0 = ltid(); if (t0 < 2) bst[t0] = 0u; }
    __syncthreads();
    (void)xcd_barrier_post((unsigned*)(args.ws + WS_BAR), bst);
    for (int ph = args.ph_lo; ph < args.ph_hi; ++ph) {
    unsigned char* ws = args.ws; asm volatile("" : "+s"(ws));
    const float* rope = (const float*)(ws + WS_ROPE);
    u64* ssq_all = (u64*)(ws + WS_SSQ);
    unsigned char* dob = (unsigned char*)args.out; asm volatile("" : "+s"(dob));
    bf16_t* XB = (bf16_t*)(ws + WS_XB); bf16_t* AO = (bf16_t*)(dob + DO_AO);
    bf16_t* Qd = (bf16_t*)(dob + DO_QD); bf16_t* Kd = (bf16_t*)(dob + DO_KD); bf16_t* Vd = (bf16_t*)(ws + WS_VD);
    bf16_t* CQ = (bf16_t*)(ws + WS_CQ); bf16_t* CKV = nullptr;
    bf16_t* Qm = (bf16_t*)(ws + WS_QM); bf16_t* Km = (bf16_t*)(ws + WS_KM); bf16_t* Vm = (bf16_t*)(ws + WS_VM);
    bf16_t* ACT = (bf16_t*)(ws + WS_ACT);
    {
        if (ph == 0 && (PHMASK & 1)) {
            float* tile = (float*)lds;
            constexpr int nIn = 32 * 16, nQR = 16, nO = 16 * 8, nGU = 88 * 16, nD = 16 * 44, nL = nIn + nQR + nO + nGU + nD;
#pragma unroll 1
            for (int it = bx; it < DEPTH * nL; it += G) {
                const int l = it / nL; int r = it % nL; unsigned char* wl = ws + WS_W + l * W_LAYER;
                if (r < nIn) { prep_item(args.in[3] + (size_t)l * DM * IN_COLS, nullptr, args.in[2] + l * DM, DM, IN_COLS, W_IN, (bf16_t*)(wl + OW_IN), r, 16, tile); continue; } r -= nIn;
                if (r < nQR) { prep_item(args.in[10] + (size_t)l * 256 * 768, nullptr, args.in[9] + l * 256, 256, 768, W_Q, (bf16_t*)(wl + OW_Q), 32 + r, 4, tile); continue; } r -= nQR;
                if (r < nO) { prep_item(args.in[13] + (size_t)l * DM * DM, nullptr, nullptr, DM, DM, W_O, (bf16_t*)(wl + OW_O), (r >> 3) * 16 + (r & 7), 16, tile); continue; } r -= nO;
                if (r < nGU) { prep_item(args.in[15] + (size_t)l * DM * DFF, args.in[16] + (size_t)l * DM * DFF, args.in[14] + l * DM, DM, DFF, W_GU, (bf16_t*)(wl + OW_GU), r, 16, tile); continue; } r -= nGU;
                prep_item(args.in[17] + (size_t)l * DFF * DM, nullptr, nullptr, DFF, DM, W_D, (bf16_t*)(wl + OW_D), r, 44, tile);
            }
#pragma unroll 1
            for (int t = bx * 128 + ltid(); t < DEPTH * 16384 && ltid() < 128; t += G * 128) { asm volatile("" : "+v"(t)); absorb_qk(args.in[10], args.in[9], args.in[12], args.in[11], ws, t); }
#pragma unroll 1
            for (int t = bx * NTHR + ltid(); t < DEPTH * 65536; t += G * NTHR) { asm volatile("" : "+v"(t)); absorb_vo(args.in[12], args.in[11], args.in[13], ws, t); }
#pragma unroll 1
            for (int e = bx * NTHR + ltid(); e < SEQ * 32; e += G * NTHR) { asm volatile("" : "+v"(e));
                const int pos = e >> 5, i = e & 31;
                const float inv = __builtin_amdgcn_exp2f(-(float)i * (13.287712379549449f / 32.0f));
                float t = ((float)pos * inv) * 0.15915494309189535f; t -= floorf(t);
                float* rt = (float*)(ws + WS_ROPE);
                rt[pos * 64 + i] = __builtin_amdgcn_cosf(t); rt[pos * 64 + 32 + i] = __builtin_amdgcn_sinf(t);
            }
#pragma unroll 1
            for (int e = bx * NTHR + ltid(); e < 8 * MTOT; e += G * NTHR) { asm volatile("" : "+v"(e)); ssq_all[MTOT + e] = 0ull; }
        } else {
            const int c = (ph - 1) / PPC, q = (ph - 1) % PPC;
            const int rows = MTOT, rbase = 0, nseq = rows / SEQ; (void)c;
            const float* xin0 = args.in[0]; const float* xin1 = args.in[1] - (size_t)ROWS0 * DM;
            float* outc = args.out + (size_t)rbase * DM;
            if (q == PPC - 1) {
                const int tq = ltid(), lane = tq & 63, wave = __builtin_amdgcn_readfirstlane(tq >> 6);
                const float* gf = args.in[18];
                f32x4 gg[4];
#pragma unroll
                for (int j = 0; j < 4; ++j) gg[j] = ld4g(gf + 4 * lane + 256 * j);
                const u64* ssqf = ssq_all + (size_t)8 * MTOT + rbase;
                const int NGW = G * NWAVES;
                int row = vcu * NWAVES + wave;
#pragma unroll 1
                for (; row < rows; row += 4 * NGW) {
                    unsigned long long v[4][4]; float rs[4];
#pragma unroll
                    for (int b = 0; b < 4; ++b) { const int rr = (row + b * NGW < rows) ? row + b * NGW : row;
                        rs[b] = __builtin_amdgcn_rsqf(ldssq(ssqf + rr) * (1.0f / 1024.0f) + EPS);
                        const GAS unsigned long long* xr = (const GAS unsigned long long*)(XB + (size_t)rr * DM) + lane;
#pragma unroll
                        for (int j = 0; j < 4; ++j) v[b][j] = xr[64 * j]; }
#pragma unroll
                    for (int b = 0; b < 4; ++b) { const int rr = row + b * NGW; if (rr < rows) {
                        float* orow = outc + (size_t)rr * DM + 4 * lane;
#pragma unroll
                        for (int j = 0; j < 4; ++j) { const unsigned lo = (unsigned)v[b][j], hi = (unsigned)(v[b][j] >> 32);
                            const f32x4 x = {__uint_as_float(lo << 16), __uint_as_float(lo & 0xffff0000u), __uint_as_float(hi << 16), __uint_as_float(hi & 0xffff0000u)};
                            st4g(orow + 256 * j, x * rs[b] * gg[j]); } } }
                }
            } else if (q == 0 && (PHMASK & 4)) {
                const int tq = ltid(), lane = tq & 63, wave = __builtin_amdgcn_readfirstlane(tq >> 6);
                u64* ssq0 = ssq_all + rbase;
                const int NGW = G * NWAVES;
                int row = vcu * NWAVES + wave;
#pragma unroll 1
                for (; row + 3 * NGW < rows; row += 4 * NGW) {
                    f32x4 v[4][4];
#pragma unroll
                    for (int b = 0; b < 4; ++b) { const int rq = row + b * NGW; const f32x4* xr = (const f32x4*)((rq < ROWS0 ? xin0 : xin1) + (size_t)rq * DM) + lane;
#pragma unroll
                        for (int j = 0; j < 4; ++j) v[b][j] = xr[64 * j]; }
#pragma unroll
                    for (int b = 0; b < 4; ++b) { const int rr = row + b * NGW;
                        float sm = 0.f; unsigned long long* o8 = (unsigned long long*)(XB + (size_t)rr * DM) + lane;
#pragma unroll
                        for (int j = 0; j < 4; ++j) { const f32x4 w = v[b][j]; sm += (w[0] * w[0] + w[1] * w[1]) + (w[2] * w[2] + w[3] * w[3]);
                            o8[64 * j] = (unsigned long long)cvt_pk_bf16(w[0], w[1]) | ((unsigned long long)cvt_pk_bf16(w[2], w[3]) << 32); }
                        sm = wave_sum(sm);
                        if (lane == 0) ssq0[rr] = (u64)(sm * SSQ_FX); }
                }
#pragma unroll 1
                for (; row < rows; row += NGW) {
                    const f32x4* xr = (const f32x4*)((row < ROWS0 ? xin0 : xin1) + (size_t)row * DM) + lane; float sm = 0.f;
                    unsigned long long* o8 = (unsigned long long*)(XB + (size_t)row * DM) + lane;
#pragma unroll
                    for (int j = 0; j < 4; ++j) { const f32x4 w = xr[64 * j]; sm += (w[0] * w[0] + w[1] * w[1]) + (w[2] * w[2] + w[3] * w[3]);
                        o8[64 * j] = (unsigned long long)cvt_pk_bf16(w[0], w[1]) | ((unsigned long long)cvt_pk_bf16(w[2], w[3]) << 32); }
                    sm = wave_sum(sm);
                    if (lane == 0) ssq0[row] = (u64)(sm * SSQ_FX);
                }
            } else {
                const int l = (q - 1) / PPL, k0 = (q - 1) % PPL, k = (k0 < 6) ? k0 : REPK;
                unsigned char* wl = ws + WS_W + l * W_LAYER;
                const u64* ssq_in = (l == 0) ? ssq_all + rbase : ssq_all + (size_t)(1 + 3) * MTOT + rbase;
                u64* ssq_q = ssq_all + (size_t)(1 + 4 * l + 0) * MTOT + rbase;
                u64* ssq_kv = ssq_all + (size_t)(1 + 4 * l + 1) * MTOT + rbase;
                u64* ssq_ffn = ssq_all + (size_t)(1 + 4 * l + 2) * MTOT + rbase;
                u64* ssq_x = ssq_all + (size_t)(1 + 4 * l + 3) * MTOT + rbase;
                if (k == 0 && (PHMASK & 8)) {
                    pg8::Gemm g{XB, (const bf16_t*)(wl + OW_IN), rows, IN_PHYS, DM}; pg8::StaticOrder S; S.init(rows, IN_PHYS, G, bx);
                    EpiIn E{Qd, Kd, Vd, CQ, CKV, Km, ssq_in, ssq_q, ssq_kv, rope};
                    pg8::gemm_phase<EpiIn, pg8::StaticOrder, PG8_ALIGN, PG8_SP2>(lds3, g, S, E);
                } else if (k == 1 && (PHMASK & 16)) {
                    {
                        const int tq = ltid(), lane = tq & 63, wave = __builtin_amdgcn_readfirstlane(tq >> 6); const int NGW = G * NWAVES;
#pragma unroll 1
                        for (int row = vcu * NWAVES + wave; row < rows; row += 4 * NGW) {
                            unsigned v[4]; float rs[4];
#pragma unroll
                            for (int b = 0; b < 4; ++b) { const int rr = (row + b * NGW < rows) ? row + b * NGW : row;
                                rs[b] = __builtin_amdgcn_rsqf(ldssq(ssq_kv + rr) * (1.0f / 128.0f) + EPS);
                                v[b] = *((const GAS unsigned*)(Km + (size_t)rr * 192) + lane); }
#pragma unroll
                            for (int b = 0; b < 4; ++b) { const int rr = row + b * NGW; if (rr < rows)
                                *((GAS unsigned*)(Km + (size_t)rr * 192) + lane) = cvt_pk_bf16(__uint_as_float(v[b] << 16) * rs[b], __uint_as_float(v[b] & 0xffff0000u) * rs[b]); }
                        }
                    }
                    pg8::Gemm g{CQ, (const bf16_t*)(wl + OW_Q), rows, 768, 256}; pg8::StaticOrder S; S.init(rows, 768, G, bx);
                    EpiQKV E{Qm, Km, Vm, ssq_q, ssq_kv, rope};
                    pg8::gemm_phase<EpiQKV, pg8::StaticOrder, PG8_ALIGN, PG8_SP2>(lds3, g, S, E);
                } else if (k == 2 && (PHMASK & 32)) {
                    const float lam_init = (l == 0) ? 0.2f : 0.35550906759096926f;
                    float s1 = 0.f, s2 = 0.f;
                    for (int i = 0; i < 64; ++i) { s1 += args.in[4][l * 64 + i] * args.in[5][l * 64 + i]; s2 += args.in[6][l * 64 + i] * args.in[7][l * 64 + i]; }
                    const float lam = __expf(s1) - __expf(s2) + lam_init;
                    AttnPtrs P{Qd, Kd, Vd, Qm, Km, Vm, AO, (float*)(ws + WS_STASH), args.in[8] + l * 128, lam_init};
                    const int nU = nseq * 32;
                    for (int u = vcu; u < 2 * nU; u += G) {
                        const int kind = u / nU, v = u % nU, qb = v & 7, h = (v >> 3) & 3, seq = v >> 5;
#if defined(ABL)
                        if (k0 >= 6) { if (kind == 0) mla_unit<ABL>(P, v >> 5, v & 31, (char*)lds); else diff_unit<ABL>(P, seq, h, qb, lam, (char*)lds); } else
#endif
                        { if (kind == 0) { if (PHMASK & 1024) mla_unit<0>(P, v >> 5, v & 31, (char*)lds); } else { if (PHMASK & 2048) diff_unit<0>(P, seq, h, qb, lam, (char*)lds); } }
                    }
                    __syncthreads();
                } else if (k == 3 && (PHMASK & 64)) {
                    pg8::Gemm g{AO, (const bf16_t*)(wl + OW_O), rows, DM, DM}; pg8::StaticOrder S; S.init(rows, DM, G, bx);
                    EpiRes E{XB, ssq_ffn};
                    pg8::gemm_phase<EpiRes, pg8::StaticOrder, PG8_ALIGN, PG8_SP2>(lds3, g, S, E);
                } else if (k == 4 && (PHMASK & 128)) {
                    pg8::Gemm g{XB, (const bf16_t*)(wl + OW_GU), rows, GU_PHYS, DM}; pg8::StaticOrder S; S.init(rows, GU_PHYS, G, bx);
                    EpiGU E{ACT, ssq_ffn};
                    pg8::gemm_phase<EpiGU, pg8::StaticOrder, PG8_ALIGN, PG8_SP2>(lds3, g, S, E);
                } else if (k == 5 && (PHMASK & 256)) {
                    pg8::Gemm g{ACT, (const bf16_t*)(wl + OW_D), rows, DM, DFF}; pg8::StaticOrder S; S.init(rows, DM, G, bx);
                    EpiRes E{XB, ssq_x};
                    pg8::gemm_phase<EpiRes, pg8::StaticOrder, PG8_ALIGN, PG8_SP2>(lds3, g, S, E);
                }
            }
        }
        if (ph + 1 < args.ph_hi && ph != 0) { if (ph == 1) { __threadfence(); cg::this_grid().sync(); } else {
 XcdBarrier xb_; xb_.bar = (unsigned*)(ws + WS_BAR); xb_.x = xb_xcc_id(); xb_.st = (volatile LAS unsigned*)(lds3 + 131072 + 1024); xcd_barrier(xb_); } }
    }
    }
}

extern "C" void kernel_launch(void* const* d_in, const int* in_sizes, int n_in, void* d_out, int out_size, void* d_ws, size_t ws_size, hipStream_t stream) {
    static int grid = 0;
    if (grid == 0) {
        if (n_in != 19 || out_size != MTOT * DM || ws_size < WS_END) { fprintf(stderr, "kernel_launch: unexpected shapes: n_in %d out %d ws %zu (need %zu)\n", n_in, out_size, ws_size, (size_t)WS_END); grid = -1; return; }
        int dev = 0, cus = 0, per_cu = 0;
        if (hipGetDevice(&dev) != hipSuccess || hipDeviceGetAttribute(&cus, hipDeviceAttributeMultiprocessorCount, dev) != hipSuccess) { grid = -1; return; }
        if (hipFuncSetAttribute((const void*)fwd_kernel, hipFuncAttributeMaxDynamicSharedMemorySize, LDS_BYTES) != hipSuccess) { fprintf(stderr, "kernel_launch: hipFuncSetAttribute failed\n"); grid = -1; return; }
        if (hipOccupancyMaxActiveBlocksPerMultiprocessor(&per_cu, (const void*)fwd_kernel, NTHR, LDS_BYTES) != hipSuccess || per_cu < 1) { fprintf(stderr, "kernel_launch: occupancy query says %d blocks per CU\n", per_cu); per_cu = 1; }
        (void)hipGetLastError();
        grid = cus;
    }
    if (grid < 0) return;
    if (hipMemsetAsync((char*)d_ws + WS_BAR, 0, BAR_BYTES, stream) != hipSuccess) { fprintf(stderr, "kernel_launch: memset failed\n"); return; }
    Args a{};
    for (int i = 0; i < 19; ++i) a.in[i] = (const float*)d_in[i];
    a.out = (float*)d_out; a.ws = (unsigned char*)d_ws;
#if defined(MK_MULTI)
    for (int ph = 0; ph < NPHASE; ++ph) { a.ph_lo = ph; a.ph_hi = ph + 1; hipLaunchKernelGGL(fwd_kernel, dim3(grid), dim3(NTHR), LDS_BYTES, stream, a); }
#else
    a.ph_lo = 0; a.ph_hi = NPHASE;
    void* kargs[] = {&a};
    hipError_t e = hipLaunchCooperativeKernel((const void*)fwd_kernel, dim3(grid), dim3(NTHR), kargs, LDS_BYTES, stream);
    if (e != hipSuccess) fprintf(stderr, "kernel_launch: cooperative launch failed: %s (grid %d)\n", hipGetErrorString(e), grid);
#endif
}
```
